# Optimizing an MI355X kernel written in HIP

```python
import math
import jax, jax.numpy as jnp
from jax import lax
import numpy as np

D_MODEL = 2048
BATCH = 2
SEQ = 4096
DEPTH = 4

EXPAND = 2
D_INNER = EXPAND * D_MODEL
HEAD_DIM = 128
D_A = D_INNER // 2
D_B = D_INNER - D_A
H_A = D_A // HEAD_DIM
H_B = D_B // HEAD_DIM
DIFF_QK_DIM = HEAD_DIM // 2
H_C = D_INNER // HEAD_DIM
P_IN = 4 * D_INNER
DILATED_PATTERNS = ((128, 1), (512, 4), (2048, 16))
N_BUCKETS = 32
MAX_DISTANCE = 2048
H_BIAS = H_A + H_B
Q_BLOCK = 128
A_Q_BLOCK = 16
N_EVEN = (DEPTH + 1) // 2
EPS = 1e-6

kernel_name = "hybrid_dilated_diff_stickbreak_trunk"


def rms_norm(x, g):
    xf = x.astype(jnp.float32)
    y = xf * lax.rsqrt(jnp.mean(xf * xf, axis=-1, keepdims=True) + EPS)
    return (y * g.astype(jnp.float32)).astype(x.dtype)


def t5_bucket(dist):
    max_exact = N_BUCKETS // 2
    d = jnp.maximum(dist, 1).astype(jnp.float32)
    large = max_exact + (jnp.log(d / max_exact) / math.log(MAX_DISTANCE / max_exact)
                         * (N_BUCKETS - max_exact)).astype(jnp.int32)
    large = jnp.minimum(large, N_BUCKETS - 1)
    return jnp.where(dist < max_exact, dist, large)


def _blocked(fn, n_blocks):
    out = lax.map(fn, jnp.arange(n_blocks))
    nb, b, qb, h, dh = out.shape
    return jnp.transpose(out, (1, 0, 2, 3, 4)).reshape(b, nb * qb, h, dh)


def dilated_attention(q, k, v, bias_table):
    s = q.shape[1]
    scale = HEAD_DIM ** -0.5
    dist = jnp.asarray(np.stack([np.arange(w // d + 1) * d for w, d in DILATED_PATTERNS]), dtype=jnp.int32)
    bias = jnp.transpose(bias_table[t5_bucket(dist)], (2, 0, 1))

    def block(i):
        start = i * A_Q_BLOCK
        t = start + jnp.arange(A_Q_BLOCK)
        kpos = t[:, None, None] - dist[None]
        valid = kpos >= 0
        kidx = jnp.maximum(kpos, 0)
        qb = lax.dynamic_slice_in_dim(q, start, A_Q_BLOCK, axis=1)
        kb = k[:, kidx]
        vb = v[:, kidx]
        logits = jnp.einsum('bqhd,bqgjhd->bhqgj', qb, kb) * scale + bias[:, None]
        logits = jnp.where(valid, logits, -jnp.inf)
        lse = jax.nn.logsumexp(logits, axis=-1)
        p = jnp.exp(logits - lse[..., None])
        o_g = jnp.einsum('bhqgj,bqgjhd->bqhgd', p, vb)
        w = jax.nn.softmax(lse, axis=-1)
        return jnp.einsum('bqhgd,bhqg->bqhd', o_g, w)

    return _blocked(block, s // A_Q_BLOCK)


def diff_attention(q1, q2, k1, k2, v, bias_table, lam):
    s = q1.shape[1]
    scale = DIFF_QK_DIM ** -0.5
    kpos = jnp.arange(s)

    def block(i):
        start = i * Q_BLOCK
        t = start + jnp.arange(Q_BLOCK)
        rel = t[:, None] - kpos[None, :]
        causal = rel >= 0
        bias = jnp.transpose(bias_table[t5_bucket(jnp.maximum(rel, 0))], (2, 0, 1))

        def softmax_map(q, k):
            qb = lax.dynamic_slice_in_dim(q, start, Q_BLOCK, axis=1)
            logits = jnp.einsum('bqhd,bshd->bhqs', qb, k) * scale + bias
            return jax.nn.softmax(jnp.where(causal, logits, -jnp.inf), axis=-1)

        a = softmax_map(q1, k1) - lam * softmax_map(q2, k2)
        return jnp.einsum('bhqs,bshd->bqhd', a, v)

    return _blocked(block, s // Q_BLOCK)


def stick_breaking_attention(q, k, v):
    s = q.shape[1]
    scale = HEAD_DIM ** -0.5
    kpos = jnp.arange(s)

    def block(i):
        start = i * Q_BLOCK
        t = start + jnp.arange(Q_BLOCK)
        strict = kpos[None, :] < t[:, None]
        qb = lax.dynamic_slice_in_dim(q, start, Q_BLOCK, axis=1)
        z = jnp.einsum('bqhd,bshd->bhqs', qb, k) * scale
        log_beta = jax.nn.log_sigmoid(z)
        log_1m_beta = jnp.where(strict, jax.nn.log_sigmoid(-z), 0.0)
        tail = lax.cumsum(log_1m_beta, axis=3, reverse=True) - log_1m_beta
        a = jnp.where(strict, jnp.exp(log_beta + tail), 0.0)
        return jnp.einsum('bhqs,bshd->bqhd', a, v)

    return _blocked(block, s // Q_BLOCK)


def even_mixer(mix_in, rel_bias, lam_vec, subln_g, lam_init):
    b, s = mix_in.shape[:2]
    sizes = [D_A, D_A, D_A, D_B // 2, D_B // 2, D_B // 2, D_B // 2]
    qa, ka, va, q1, q2, k1, k2, vb = jnp.split(mix_in.astype(jnp.float32), list(np.cumsum(sizes)), axis=-1)
    heads = lambda t, h, d: t.reshape(b, s, h, d)
    o_a = dilated_attention(heads(qa, H_A, HEAD_DIM), heads(ka, H_A, HEAD_DIM), heads(va, H_A, HEAD_DIM),
                            rel_bias[:, :H_A])
    lam_vec = lam_vec.astype(jnp.float32)
    lam = (jnp.exp(jnp.sum(lam_vec[0] * lam_vec[1])) - jnp.exp(jnp.sum(lam_vec[2] * lam_vec[3])) + lam_init)
    o_b = diff_attention(heads(q1, H_B, DIFF_QK_DIM), heads(q2, H_B, DIFF_QK_DIM),
                         heads(k1, H_B, DIFF_QK_DIM), heads(k2, H_B, DIFF_QK_DIM),
                         heads(vb, H_B, HEAD_DIM), rel_bias[:, H_A:], lam)
    o_b = rms_norm(o_b, subln_g) * (1.0 - lam_init)
    out = jnp.concatenate([o_a.reshape(b, s, D_A), o_b.reshape(b, s, D_B)], axis=-1)
    return out.astype(mix_in.dtype)


def odd_mixer(mix_in):
    b, s = mix_in.shape[:2]
    q, k, v = jnp.split(mix_in.astype(jnp.float32), 3, axis=-1)
    heads = lambda t: t.reshape(b, s, H_C, HEAD_DIM)
    out = stick_breaking_attention(heads(q), heads(k), heads(v))
    return out.reshape(b, s, D_INNER).astype(mix_in.dtype)


def setup_inputs(seed: int = 0) -> dict:
    key = jax.random.key(seed)
    ks = jax.random.split(key, 11)
    nrm = lambda k, shape, sc: jax.random.normal(k, shape, jnp.float32) * sc
    return {
        "x": nrm(ks[0], (BATCH, SEQ, D_MODEL), 1.0),
        "c": nrm(ks[1], (BATCH, D_MODEL), 1.0),
        "norm_g": 1.0 + nrm(ks[2], (DEPTH, D_MODEL), 0.02),
        "w_mod": nrm(ks[3], (DEPTH, D_MODEL, 3 * D_MODEL), 0.5 * D_MODEL ** -0.5),
        "b_mod": nrm(ks[4], (DEPTH, 3 * D_MODEL), 0.02),
        "w_in": nrm(ks[5], (DEPTH, D_MODEL, P_IN), D_MODEL ** -0.5),
        "w_out": nrm(ks[6], (DEPTH, D_INNER, D_MODEL), D_INNER ** -0.5),
        "rel_bias": nrm(ks[7], (N_BUCKETS, H_BIAS), 0.5),
        "diff_lambda": nrm(ks[8], (N_EVEN, 4, DIFF_QK_DIM), 0.1),
        "diff_subln_g": 1.0 + nrm(ks[9], (N_EVEN, HEAD_DIM), 0.02),
        "final_norm_g": 1.0 + nrm(ks[10], (D_MODEL,), 0.02),
    }


def reference(x, c, norm_g, w_mod, b_mod, w_in, w_out, rel_bias, diff_lambda, diff_subln_g, final_norm_g):
    h = x
    c_act = jax.nn.silu(c)
    for layer in range(DEPTH):
        mod = c_act @ w_mod[layer] + b_mod[layer]
        shift, scale, gate = jnp.split(mod, 3, axis=-1)
        u = rms_norm(h, norm_g[layer]) * (1.0 + scale[:, None]) + shift[:, None]
        proj = u @ w_in[layer]
        mix_in, z = proj[..., :3 * D_INNER], proj[..., 3 * D_INNER:]
        if layer % 2 == 0:
            e = layer // 2
            lam_init = 0.8 - 0.6 * math.exp(-0.3 * layer)
            mixed = even_mixer(mix_in, rel_bias, diff_lambda[e], diff_subln_g[e], lam_init)
        else:
            mixed = odd_mixer(mix_in)
        y = (mixed * jax.nn.silu(z)) @ w_out[layer]
        h = h + gate[:, None] * y
    return rms_norm(h, final_norm_g)
```

```cpp
#include <hip/hip_runtime.h>
#include <hip/hip_cooperative_groups.h>
#include <cstdio>
#include <cstdint>
namespace cg = cooperative_groups;
#ifndef PROBE
#define PROBE 0
#endif
namespace pg8 {
#define PG8_LAS __attribute__((address_space(3)))
typedef unsigned short bf16_t;
typedef short bf16x8 __attribute__((ext_vector_type(8)));
typedef float f32x4 __attribute__((ext_vector_type(4)));
typedef unsigned u32x4 __attribute__((ext_vector_type(4)));
constexpr int BM = 256, BK = 64, HALF = 128, HTB = HALF * BK * 2  , STAGE_BYTES = 8 * HTB, NXCD = 8, WGM = 4;

__host__ __device__ __forceinline__ int lds_byte(int r, int c) { const int st = (r >> 4) * 2 + (c >> 5), rr = r & 15, cc = c & 31, ob = rr * 64 + cc * 2; return st * 1024 + (ob ^ (((ob >> 9) & 1) << 5)); }
__host__ __device__ __forceinline__ void stage_rc(int b, int& R, int& C) { const int st = b / 1024, sb = b % 1024, swz = sb ^ (((sb >> 9) & 1) << 5); R = (st >> 1) * 16 + swz / 64; C = (st & 1) * 32 + (swz % 64) / 2; }
__host__ __device__ __forceinline__ int perm32(int rho) { const int n = rho >> 4, i = rho & 15; return 8 * (i >> 2) + 4 * n + (i & 3); }

struct Unit { int pm, pn; };
struct Gemm { const bf16_t* A; const bf16_t* Bt; int M, N, K; };

struct StaticOrder {
    int nM, nN, nwg, G, c;
    __host__ __device__ void init(int M, int N, int G_, int c_) { nM = M / BM; nN = N / BM; nwg = nM * nN; G = G_; c = c_; }
    __host__ __device__ bool next(int i, Unit& u) const {
        const long L = (long)i * G + c; if (L >= nwg) return false;
        int wgid = (int)L; { const int q = nwg / NXCD, r = nwg % NXCD, xcd = wgid % NXCD, off = wgid / NXCD; wgid = (xcd < r ? xcd * (q + 1) : r * (q + 1) + (xcd - r) * q) + off; }
        const int nig = WGM * nN, gid = wgid / nig, fm = gid * WGM, gsz = (nM - fm) < WGM ? (nM - fm) : WGM;
        u.pm = fm + ((wgid % nig) % gsz); u.pn = (wgid % nig) / gsz; return true;
    }
    __device__ __forceinline__ void a_ready(const Unit&) const {}
    __device__ __forceinline__ void done(const Unit&) const {}
};

__device__ __forceinline__ unsigned cvt_pk_bf16(float lo, float hi) { unsigned r; asm volatile("v_cvt_pk_bf16_f32 %0, %1, %2" : "=v"(r) : "v"(lo), "v"(hi)); return r; }
typedef float f32x2 __attribute__((ext_vector_type(2)));

__device__ __forceinline__ float silu_f(float v) { return v * __builtin_amdgcn_rcpf(1.0f + __builtin_amdgcn_exp2f(v * -1.4426950408889634f)); }
struct EpiProj {
    static constexpr bool PERM = true, AFTER_DRAIN = false;
    bf16_t* O; int ldc; int act_pn0;
    __device__ __forceinline__ void operator()(const f32x4 (&acc)[2][2][4][2], const Unit& u, int wr, int wc, int fr, int fq) const {
        const int row0 = u.pm * BM + wr * 64 + fr; const int col0 = u.pn * BM + wc * 32 + 8 * fq;
        const bool act = u.pn >= act_pn0;
#pragma unroll
        for (int ai = 0; ai < 2; ++ai)
#pragma unroll
            for (int m = 0; m < 4; ++m) { bf16_t* rowp = O + (size_t)(row0 + ai * HALF + m * 16) * ldc + col0;
#pragma unroll
                for (int bj = 0; bj < 2; ++bj) { f32x4 v0 = acc[ai][bj][m][0], v1 = acc[ai][bj][m][1];
                    if (act) { v0 = (f32x4){silu_f(v0[0]), silu_f(v0[1]), silu_f(v0[2]), silu_f(v0[3])}; v1 = (f32x4){silu_f(v1[0]), silu_f(v1[1]), silu_f(v1[2]), silu_f(v1[3])}; }
                    u32x4 w; w.x = cvt_pk_bf16(v0[0], v0[1]); w.y = cvt_pk_bf16(v0[2], v0[3]); w.z = cvt_pk_bf16(v1[0], v1[1]); w.w = cvt_pk_bf16(v1[2], v1[3]);
                    *(u32x4*)(rowp + bj * HALF) = w; } }
    }
};
struct EpiRes {
    static constexpr bool PERM = false, AFTER_DRAIN = false;
    const float* hin; float* hout; const float* gate; int ldc; int gate_bstride; int rows_per_batch;
    __device__ __forceinline__ void operator()(const f32x4 (&acc)[2][2][4][2], const Unit& u, int wr, int wc, int fr, int fq) const {
        const int col0 = u.pn * BM + wc * 32 + 4 * fq; const int b = (u.pm * BM) / rows_per_batch;
        const float* gp = gate + (size_t)b * gate_bstride + col0;
#pragma unroll
        for (int bj = 0; bj < 2; ++bj)
#pragma unroll
            for (int n = 0; n < 2; ++n) { const f32x4 gv = *(const f32x4*)(gp + bj * HALF + n * 16);
#pragma unroll
                for (int ai = 0; ai < 2; ++ai)
#pragma unroll
                    for (int m = 0; m < 4; ++m) { const size_t off = (size_t)(u.pm * BM + ai * HALF + wr * 64 + m * 16 + fr) * ldc + col0 + bj * HALF + n * 16;
                        const f32x4 hv = *(const f32x4*)(hin + off); *(f32x4*)(hout + off) = hv + gv * acc[ai][bj][m][n]; } }
    }
};

struct EpiResNorm {
    static constexpr bool PERM = false, AFTER_DRAIN = true;
    const float* hin; float* hout; const float* gate; int ldc; int gate_bstride; int rows_per_batch;
    const float* ng; const float* nmod; bf16_t* uout; float* fout; float* slots; unsigned* cnt; int final_;
    __device__ __forceinline__ void fused(f32x4 (&acc)[2][2][4][2], const Unit& u, int wr, int wc, int fr, int fq, PG8_LAS unsigned char* lds, int wid, int lane) const {
        const int tid = wid * 64 + lane;
        const int col0 = u.pn * BM + wc * 32 + 4 * fq; const int b = (u.pm * BM) / rows_per_batch;
        const float* gp = gate + (size_t)b * gate_bstride + col0;
        PG8_LAS float* P = (PG8_LAS float*)lds;
        PG8_LAS float* S = (PG8_LAS float*)(lds + 4096);
#pragma unroll
        for (int bj = 0; bj < 2; ++bj)
#pragma unroll
            for (int n = 0; n < 2; ++n) { const f32x4 gv = *(const f32x4*)(gp + bj * HALF + n * 16);
#pragma unroll
                for (int ai = 0; ai < 2; ++ai)
#pragma unroll
                    for (int m = 0; m < 4; ++m) { const size_t off = (size_t)(u.pm * BM + ai * HALF + wr * 64 + m * 16 + fr) * ldc + col0 + bj * HALF + n * 16;
                        const f32x4 hv = *(const f32x4*)(hin + off) + gv * acc[ai][bj][m][n]; acc[ai][bj][m][n] = hv;
                        if (!final_) *(f32x4*)(hout + off) = hv; } }
#pragma unroll
        for (int ai = 0; ai < 2; ++ai)
#pragma unroll
            for (int m = 0; m < 4; ++m) { float q = 0.f;
#pragma unroll
                for (int bj = 0; bj < 2; ++bj)
#pragma unroll
                    for (int n = 0; n < 2; ++n) { const f32x4 x = acc[ai][bj][m][n]; q += (x[0] * x[0] + x[1] * x[1]) + (x[2] * x[2] + x[3] * x[3]); }
                q += __shfl_xor(q, 16); q += __shfl_xor(q, 32);
                if (fq == 0) P[(ai * HALF + wr * 64 + m * 16 + fr) * 4 + wc] = q; }
        asm volatile("s_waitcnt lgkmcnt(0)" ::: "memory"); __builtin_amdgcn_s_barrier(); asm volatile("" ::: "memory");
        if (tid < BM) { const float t = (P[tid * 4 + 0] + P[tid * 4 + 1]) + (P[tid * 4 + 2] + P[tid * 4 + 3]);
            __hip_atomic_store(slots + (size_t)(u.pm * BM + tid) * 8 + u.pn, t, __ATOMIC_RELAXED, __HIP_MEMORY_SCOPE_AGENT); }
        asm volatile("s_waitcnt vmcnt(0)" ::: "memory"); __builtin_amdgcn_s_barrier(); asm volatile("" ::: "memory");
        if (tid == 0) { __hip_atomic_fetch_add(cnt + 64 * u.pm, 1u, __ATOMIC_RELAXED, __HIP_MEMORY_SCOPE_AGENT);
            unsigned spins = 0u;
            while (__hip_atomic_load(cnt + 64 * u.pm, __ATOMIC_RELAXED, __HIP_MEMORY_SCOPE_AGENT) < 8u) { __builtin_amdgcn_s_sleep(2); if (++spins > (1u << 22)) break; }
            __builtin_amdgcn_fence(__ATOMIC_ACQUIRE, "agent"); }
        asm volatile("s_waitcnt vmcnt(0) lgkmcnt(0)" ::: "memory"); __builtin_amdgcn_s_barrier(); asm volatile("" ::: "memory");
        if (tid < BM) { const float* sl = slots + (size_t)(u.pm * BM + tid) * 8; float t = 0.f;
#pragma unroll
            for (int k = 0; k < 8; ++k) t += __hip_atomic_load(sl + k, __ATOMIC_RELAXED, __HIP_MEMORY_SCOPE_AGENT);
            S[tid] = 1.0f / sqrtf(t * (1.0f / 2048.0f) + 1e-6f); }
        asm volatile("s_waitcnt vmcnt(0) lgkmcnt(0)" ::: "memory"); __builtin_amdgcn_s_barrier(); asm volatile("" ::: "memory");
#pragma unroll
        for (int bj = 0; bj < 2; ++bj)
#pragma unroll
            for (int n = 0; n < 2; ++n) { const int c = col0 + bj * HALF + n * 16; const f32x4 g4 = *(const f32x4*)(ng + c);
                f32x4 sc4 = {0.f, 0.f, 0.f, 0.f}, sh4 = {0.f, 0.f, 0.f, 0.f};
                if (!final_) { sh4 = *(const f32x4*)(nmod + (size_t)b * gate_bstride + c); sc4 = *(const f32x4*)(nmod + (size_t)b * gate_bstride + 2048 + c); }
#pragma unroll
                for (int ai = 0; ai < 2; ++ai)
#pragma unroll
                    for (int m = 0; m < 4; ++m) { const int r = ai * HALF + wr * 64 + m * 16 + fr; const float rs = S[r]; const size_t off = (size_t)(u.pm * BM + r) * ldc + c;
                        f32x4 y = acc[ai][bj][m][n] * rs * g4;
                        if (final_) *(f32x4*)(fout + off) = y;
                        else { y = y * (sc4 + 1.0f) + sh4; typedef unsigned u32x2_ __attribute__((ext_vector_type(2))); u32x2_ w; w.x = cvt_pk_bf16(y[0], y[1]); w.y = cvt_pk_bf16(y[2], y[3]); *(u32x2_*)(uout + off) = w; } } }
    }
};
template <class Epi, class Sched, bool ALIGN_EPI = false, bool SP2 = false>
__device__ __forceinline__ void gemm_phase(PG8_LAS unsigned char* lds, const Gemm g, const Sched& S, const Epi& E) {
    int tid0_ = threadIdx.x; asm volatile("" : "+v"(tid0_));
    const int tid = tid0_, wid = __builtin_amdgcn_readfirstlane(tid >> 6), lane = tid & 63, wr = wid >> 2, wc = wid & 3, fr = lane & 15, fq = lane >> 4;
    const int K = g.K, nt = K / BK;
    unsigned voffA[2], voffB[2];
#pragma unroll
    for (int i = 0; i < 2; ++i) { int R, C; stage_rc(tid * 16 + i * 8192, R, C); const int Rb = Epi::PERM ? ((R & ~31) + perm32(R & 31)) : R;
        voffA[i] = (unsigned)(R * K + C) * 2u; voffB[i] = (unsigned)(Rb * K + C) * 2u; }
    const size_t kstep = (size_t)(BK * 2);
    const size_t hstep = (size_t)HALF * K * 2;
    const size_t tstep = 2 * hstep;
    const unsigned ldsw = (unsigned)wid * 1024u;
    const int aoff = lds_byte(wr * 64 + fr, fq * 8), boff = lds_byte(wc * 32 + fr, fq * 8);
#define PG8_SA(b, h) (((b) * 2 + (h)) * HTB)
#define PG8_SB(b, h) ((4 + (b) * 2 + (h)) * HTB)
#define PG8_STAGE(bufoff, gbase, voff) do { _Pragma("unroll") for (int _i = 0; _i < 2; ++_i) \
        __builtin_amdgcn_global_load_lds((const unsigned*)((const char*)(gbase) + (voff)[_i]), (PG8_LAS unsigned*)(lds + (bufoff) + ldsw + _i * 8192), 16, 0, 0); } while (0)
#define PG8_LDA(dst, b, h) do { _Pragma("unroll") for (int m = 0; m < 4; ++m) _Pragma("unroll") for (int k = 0; k < 2; ++k) dst[m][k] = *(const PG8_LAS bf16x8*)(lds + PG8_SA(b, h) + aoff + m * 2048 + k * 1024); } while (0)
#define PG8_LDB(dst, b, h) do { _Pragma("unroll") for (int n = 0; n < 2; ++n) _Pragma("unroll") for (int k = 0; k < 2; ++k) dst[n][k] = *(const PG8_LAS bf16x8*)(lds + PG8_SB(b, h) + boff + n * 2048 + k * 1024); } while (0)
#define PG8_MMA(ai, bj, At, Bt) do { __builtin_amdgcn_s_setprio(1); _Pragma("unroll") for (int m = 0; m < 4; ++m) _Pragma("unroll") for (int n = 0; n < 2; ++n) _Pragma("unroll") for (int k = 0; k < 2; ++k) \
        acc[ai][bj][m][n] = __builtin_amdgcn_mfma_f32_16x16x32_bf16(Bt[n][k], At[m][k], acc[ai][bj][m][n], 0, 0, 0); __builtin_amdgcn_s_setprio(0); } while (0)
#define PG8_WAIT_V(n) asm volatile("s_waitcnt vmcnt(" #n ")" ::: "memory")
#define PG8_WAIT_L(n) asm volatile("s_waitcnt lgkmcnt(" #n ")" ::: "memory")
#define PG8_BAR __builtin_amdgcn_s_barrier()
#define PG8_SCHED __builtin_amdgcn_sched_barrier(0)
    Unit cur, nxt; int ui = 0;
    if (!S.next(0, cur)) return;
    f32x4 acc[2][2][4][2];
#pragma unroll
    for (int a = 0; a < 2; ++a)
#pragma unroll
        for (int b = 0; b < 2; ++b)
#pragma unroll
            for (int m = 0; m < 4; ++m)
#pragma unroll
                for (int n = 0; n < 2; ++n) acc[a][b][m][n] = (f32x4){0.f, 0.f, 0.f, 0.f};
    bf16x8 At[4][2], B0[2][2], B1[2][2];
    const char* cA = (const char*)g.A + (size_t)cur.pm * tstep; const char* cB = (const char*)g.Bt + (size_t)cur.pn * tstep;
    S.a_ready(cur);
    if constexpr (SP2) {
        PG8_STAGE(PG8_SB(0, 0), cB, voffB); PG8_STAGE(PG8_SB(0, 1), cB + hstep, voffB); PG8_STAGE(PG8_SA(0, 0), cA, voffA); PG8_STAGE(PG8_SA(0, 1), cA + hstep, voffA);
        if (wr == 1) PG8_BAR;
        PG8_WAIT_V(2); PG8_BAR;
        PG8_STAGE(PG8_SB(1, 0), cB + kstep, voffB); PG8_STAGE(PG8_SA(1, 0), cA + kstep, voffA); PG8_STAGE(PG8_SB(1, 1), cB + hstep + kstep, voffB);
        PG8_WAIT_V(6); PG8_BAR;
    } else {
        PG8_STAGE(PG8_SB(0, 0), cB, voffB); PG8_STAGE(PG8_SA(0, 0), cA, voffA); PG8_STAGE(PG8_SB(0, 1), cB + hstep, voffB); PG8_STAGE(PG8_SA(0, 1), cA + hstep, voffA);
        if (wr == 1) PG8_BAR;
        PG8_WAIT_V(4); PG8_BAR;
        PG8_STAGE(PG8_SB(1, 0), cB + kstep, voffB); PG8_STAGE(PG8_SA(1, 0), cA + kstep, voffA); PG8_STAGE(PG8_SB(1, 1), cB + hstep + kstep, voffB);
        PG8_WAIT_V(6); PG8_BAR;
    }
    for (;;) {
        const bool has_next = S.next(ui + 1, nxt);
        const char* nA = has_next ? (const char*)g.A + (size_t)nxt.pm * tstep : cA; const char* nB = has_next ? (const char*)g.Bt + (size_t)nxt.pn * tstep : cB;
        for (int t = 0; t < nt; t += 2) {
            const bool last = (t == nt - 2);
            const char* a1 = cA + (size_t)(t + 1) * kstep;
            const char* a2 = last ? nA : cA + (size_t)(t + 2) * kstep; const char* b2 = last ? nB : cB + (size_t)(t + 2) * kstep;
            const char* a3 = a2 + kstep; const char* b3 = b2 + kstep;
            if (last && has_next) S.a_ready(nxt);
            if constexpr (SP2) {
            PG8_LDB(B0, 0, 0); PG8_LDB(B1, 0, 1); PG8_SCHED; PG8_LDA(At, 0, 0); PG8_STAGE(PG8_SA(1, 1), a1 + hstep, voffA);
            PG8_WAIT_V(8); PG8_WAIT_L(0); PG8_BAR; PG8_MMA(0, 0, At, B0); PG8_MMA(0, 1, At, B1); PG8_BAR; PG8_SCHED;
            PG8_LDA(At, 0, 1); PG8_STAGE(PG8_SB(0, 0), b2, voffB); PG8_STAGE(PG8_SB(0, 1), b2 + hstep, voffB); PG8_STAGE(PG8_SA(0, 0), a2, voffA);
            PG8_WAIT_V(8); PG8_WAIT_L(0); PG8_BAR; PG8_MMA(1, 0, At, B0); PG8_MMA(1, 1, At, B1); PG8_BAR; PG8_SCHED;
            PG8_LDB(B0, 1, 0); PG8_LDB(B1, 1, 1); PG8_SCHED; PG8_LDA(At, 1, 0); PG8_STAGE(PG8_SA(0, 1), a2 + hstep, voffA);
            PG8_WAIT_V(8); PG8_WAIT_L(0); PG8_BAR; PG8_MMA(0, 0, At, B0); PG8_MMA(0, 1, At, B1); PG8_BAR; PG8_SCHED;
            PG8_LDA(At, 1, 1); PG8_STAGE(PG8_SB(1, 0), b3, voffB); PG8_STAGE(PG8_SB(1, 1), b3 + hstep, voffB); PG8_STAGE(PG8_SA(1, 0), a3, voffA);
            PG8_WAIT_V(8); PG8_WAIT_L(0); PG8_BAR; PG8_MMA(1, 0, At, B0); PG8_MMA(1, 1, At, B1); PG8_BAR; PG8_SCHED;
            } else {
            PG8_LDB(B0, 0, 0); PG8_SCHED; PG8_LDA(At, 0, 0); PG8_STAGE(PG8_SA(1, 1), a1 + hstep, voffA);
            PG8_WAIT_L(8); PG8_BAR; PG8_WAIT_L(0); PG8_MMA(0, 0, At, B0); PG8_BAR; PG8_SCHED;
            PG8_LDB(B1, 0, 1); PG8_STAGE(PG8_SB(0, 0), b2, voffB);
            PG8_BAR; PG8_WAIT_L(0); PG8_MMA(0, 1, At, B1); PG8_BAR;
            PG8_LDA(At, 0, 1); PG8_STAGE(PG8_SA(0, 0), a2, voffA);
            PG8_BAR; PG8_WAIT_L(0); PG8_MMA(1, 0, At, B0); PG8_BAR; PG8_SCHED;
            PG8_STAGE(PG8_SB(0, 1), b2 + hstep, voffB);
            PG8_WAIT_V(6); PG8_BAR; PG8_MMA(1, 1, At, B1); PG8_BAR;
            PG8_LDB(B0, 1, 0); PG8_SCHED; PG8_LDA(At, 1, 0); PG8_STAGE(PG8_SA(0, 1), a2 + hstep, voffA);
            PG8_WAIT_L(8); PG8_BAR; PG8_WAIT_L(0); PG8_MMA(0, 0, At, B0); PG8_BAR; PG8_SCHED;
            PG8_LDB(B1, 1, 1); PG8_STAGE(PG8_SB(1, 0), b3, voffB);
            PG8_BAR; PG8_WAIT_L(0); PG8_MMA(0, 1, At, B1); PG8_BAR;
            PG8_LDA(At, 1, 1); PG8_STAGE(PG8_SA(1, 0), a3, voffA);
            PG8_BAR; PG8_WAIT_L(0); PG8_MMA(1, 0, At, B0); PG8_BAR; PG8_SCHED;
            PG8_STAGE(PG8_SB(1, 1), b3 + hstep, voffB);
            PG8_WAIT_V(6); PG8_BAR; PG8_MMA(1, 1, At, B1); PG8_BAR;
            }
        }
        if constexpr (ALIGN_EPI) { if (wr == 0) PG8_BAR; }
        if constexpr (!Epi::AFTER_DRAIN) { E(acc, cur, wr, wc, fr, fq); S.done(cur); }
        if (!has_next) break;
#pragma unroll
        for (int a = 0; a < 2; ++a)
#pragma unroll
            for (int b = 0; b < 2; ++b)
#pragma unroll
                for (int m = 0; m < 4; ++m)
#pragma unroll
                    for (int n = 0; n < 2; ++n) acc[a][b][m][n] = (f32x4){0.f, 0.f, 0.f, 0.f};
        cur = nxt; cA = nA; cB = nB; ++ui;
        if constexpr (ALIGN_EPI) { if (wr == 1) PG8_BAR; }
    }
    PG8_WAIT_V(0);
    if constexpr (!ALIGN_EPI) { if (wr == 0) PG8_BAR; }
    PG8_BAR;
    if constexpr (Epi::AFTER_DRAIN) { E.fused(acc, cur, wr, wc, fr, fq, lds, wid, lane); S.done(cur); }
#undef PG8_SA
#undef PG8_SB
#undef PG8_STAGE
#undef PG8_LDA
#undef PG8_LDB
#undef PG8_MMA
#undef PG8_WAIT_V
#undef PG8_WAIT_L
#undef PG8_BAR
#undef PG8_SCHED
}
}

constexpr int NB = 2, SEQ = 4096, DM = 2048, MTOK = NB * SEQ, DI = 4096, PIN = 16384, PINP = PIN + 128  , DEPTH = 4, NMOD = 3 * DM;
constexpr float EPS = 1e-6f, LOG2E = 1.4426950408889634f, LN2 = 0.6931471805599453f;
constexpr size_t MiB = 1u << 20;
constexpr size_t WS_WIN = 0, WS_WOUT = 256 * MiB, WS_U = 320 * MiB, WS_PROJ = 352 * MiB, WS_G = 612 * MiB, WS_H = 676 * MiB,
                 WS_MOD = 740 * MiB, WS_LSE = 741 * MiB, WS_OG = 744 * MiB, WS_BAR = 840 * MiB, WS_END = 841 * MiB;
static_assert(WS_PROJ + (size_t)MTOK * PINP * 2 <= WS_G, "ws map");
constexpr int LDS_BYTES = 158720, LDS_BARST = 158656;
constexpr int CW_PANEL = 4096  , CW_WORDS = CW_PANEL + DEPTH * 32 * 64;
constexpr size_t WS_SLOTS = WS_BAR + 512 * 1024;

#define GAS __attribute__((address_space(1)))
#define LAS __attribute__((address_space(3)))
typedef unsigned short bf16;
typedef unsigned v4u __attribute__((ext_vector_type(4)));
typedef unsigned v2u __attribute__((ext_vector_type(2)));
typedef float f32x4 __attribute__((ext_vector_type(4)));
typedef float f32x16 __attribute__((ext_vector_type(16)));
typedef short bf16x8 __attribute__((ext_vector_type(8)));
typedef short s16x4 __attribute__((ext_vector_type(4)));
#define LDS_WAIT() asm volatile("s_waitcnt lgkmcnt(0)" ::: "memory")
__device__ __forceinline__ unsigned f2bf(float f) { unsigned u = __builtin_bit_cast(unsigned, f); return (u + 0x7fffu + ((u >> 16) & 1u)) >> 16; }
__device__ __forceinline__ unsigned pk2(float lo, float hi) { return f2bf(lo) | (f2bf(hi) << 16); }
__device__ __forceinline__ float bf2f(unsigned short h) { return __builtin_bit_cast(float, (unsigned)h << 16); }
__device__ __forceinline__ float bflo(unsigned w) { return __builtin_bit_cast(float, w << 16); }
__device__ __forceinline__ float bfhi(unsigned w) { return __builtin_bit_cast(float, w & 0xffff0000u); }
typedef float f32x2_t __attribute__((ext_vector_type(2))); typedef __bf16 bf16x2_t __attribute__((ext_vector_type(2)));
__device__ __forceinline__ unsigned cvtpk(float lo, float hi) { f32x2_t v = {lo, hi}; bf16x2_t b = __builtin_convertvector(v, bf16x2_t); return __builtin_bit_cast(unsigned, b); }
__device__ __forceinline__ float wave_sum(float v) {
#pragma unroll
    for (int o = 1; o < 64; o <<= 1) v += __shfl_xor(v, o);
    return v;
}
__device__ __forceinline__ float xpartner(float v, int hi) { auto rr = __builtin_amdgcn_permlane32_swap(__float_as_uint(v), __float_as_uint(v), false, false); return __uint_as_float(hi ? rr[0] : rr[1]); }
__device__ __forceinline__ float xmax(float v) { auto rr = __builtin_amdgcn_permlane32_swap(__float_as_uint(v), __float_as_uint(v), false, false); return fmaxf(__uint_as_float(rr[0]), __uint_as_float(rr[1])); }
__device__ __forceinline__ float xsum(float v) { auto rr = __builtin_amdgcn_permlane32_swap(__float_as_uint(v), __float_as_uint(v), false, false); return __uint_as_float(rr[0]) + __uint_as_float(rr[1]); }
__device__ __forceinline__ int crow(int r, int hi) { return (r & 3) + 8 * (r >> 2) + 4 * hi; }
__device__ __forceinline__ float silu(float v) { return v / (1.0f + __expf(-v)); }
__device__ __forceinline__ int t5_bucket(int rel) {
    if (rel < 16) return rel < 0 ? 0 : rel;
    int bk = 16;
    bk += rel >= 22; bk += rel >= 30; bk += rel >= 40; bk += rel >= 54; bk += rel >= 73; bk += rel >= 99; bk += rel >= 134; bk += rel >= 182;
    bk += rel >= 246; bk += rel >= 332; bk += rel >= 450; bk += rel >= 609; bk += rel >= 825; bk += rel >= 1117; bk += rel >= 1513;
    return bk;
}
__device__ __forceinline__ s16x4 vtr(const LAS char* p) { return __builtin_bit_cast(s16x4, __builtin_amdgcn_ds_read_tr16_b64_v4i16((LAS s16x4*)p)); }
#define MFMA32(a, b, c) __builtin_amdgcn_mfma_f32_32x32x16_bf16((a), (b), (c), 0, 0, 0)

__device__ __forceinline__ int opaque_tid() { int t = threadIdx.x; asm volatile("" : "+v"(t)); return t; }
struct Args { const float *x, *c, *norm_g, *w_mod, *b_mod, *w_in, *w_out, *rel_bias, *diff_lambda, *diff_subln_g, *final_norm_g; float* out; unsigned char* ws; };

__device__ __forceinline__ void p0_transpose_item(const float* W, int K, int N, bf16* WT, int row_off, LAS float* scr, int item, int lane) {
    const int nblk = N / 32, kb = item / nblk, nb = item % nblk, k0 = 64 * kb, n0 = 32 * nb;
#pragma unroll 8
    for (int i = 0; i < 32; ++i) { const int kk = 2 * i + (lane >> 5); scr[kk * 33 + (lane & 31)] = W[(size_t)(k0 + kk) * N + n0 + (lane & 31)]; }
    LDS_WAIT(); asm volatile("" ::: "memory");
    const int c = lane & 7;
#pragma unroll
    for (int j = 0; j < 4; ++j) { const int n = (lane >> 3) + 8 * j; const LAS float* s = scr + (8 * c) * 33 + n;
        v4u o; o.x = pk2(s[0 * 33], s[1 * 33]); o.y = pk2(s[2 * 33], s[3 * 33]); o.z = pk2(s[4 * 33], s[5 * 33]); o.w = pk2(s[6 * 33], s[7 * 33]);
        *(GAS v4u*)(WT + (size_t)(row_off + n0 + n) * K + k0 + 8 * c) = o; }
    LDS_WAIT(); asm volatile("" ::: "memory");
}
__device__ __forceinline__ void p0_prologue(const Args& a, LAS unsigned char* lds, int G) {
    const int tid = opaque_tid(), lane = tid & 63, wave = tid >> 6;
    LAS float* cs = (LAS float*)lds;
    LAS float* red = (LAS float*)(lds + 16384);
    float* MOD = (float*)(a.ws + WS_MOD);
    for (int i = tid; i < NB * DM; i += 512) cs[i] = silu(a.c[i]);
    __syncthreads();
    for (int item = blockIdx.x; item < DEPTH * (NMOD / 64); item += G) {
        const int l = item / (NMOD / 64), n0 = (item % (NMOD / 64)) * 64, kq = tid >> 4, cq = tid & 15;
        const float* W = a.w_mod + (size_t)l * DM * NMOD + n0 + 4 * cq;
        f32x4 a0 = {0.f, 0.f, 0.f, 0.f}, a1 = {0.f, 0.f, 0.f, 0.f};
#pragma unroll 8
        for (int k = kq; k < DM; k += 32) { const f32x4 w = *(const f32x4*)(W + (size_t)k * NMOD); a0 += w * cs[k]; a1 += w * cs[DM + k]; }
        *(LAS f32x4*)(red + (kq * 2 + 0) * 64 + 4 * cq) = a0; *(LAS f32x4*)(red + (kq * 2 + 1) * 64 + 4 * cq) = a1;
        __syncthreads();
        if (tid < 128) { const int b = tid >> 6, col = tid & 63; float s = 0.f;
#pragma unroll 8
            for (int q = 0; q < 32; ++q) s += red[(q * 2 + b) * 64 + col];
            MOD[((size_t)l * NB + b) * NMOD + n0 + col] = s + a.b_mod[(size_t)l * NMOD + n0 + col]; }
        __syncthreads();
    }
    __syncthreads();
    LAS float* scr = (LAS float*)(lds + wave * 16384);
    const int gw = blockIdx.x * 8 + wave, NGW = G * 8;
    constexpr int I_IN = (DM / 64) * (PIN / 32), I_OUT = (DI / 64) * (DM / 32);
    for (int it = gw; it < DEPTH * (I_IN + I_OUT); it += NGW) {
        const int l = it / (I_IN + I_OUT); int r = it % (I_IN + I_OUT);
        if (r < I_IN) p0_transpose_item(a.w_in + (size_t)l * DM * PIN, DM, PIN, (bf16*)(a.ws + WS_WIN) + (size_t)l * PIN * DM, 0, scr, r, lane);
        else p0_transpose_item(a.w_out + (size_t)l * DI * DM, DI, DM, (bf16*)(a.ws + WS_WOUT) + (size_t)l * DM * DI, 0, scr, r - I_IN, lane);
    }
}

template <bool FINAL> __device__ __forceinline__ void rows_phase(const float* hin, const float* g, const float* mod, bf16* uout, float* fout, int G) {
    const int tid = opaque_tid(), lane = tid & 63, gw = blockIdx.x * 8 + (tid >> 6), NGW = G * 8;
    for (int m = gw; m < MTOK; m += NGW) {
        const f32x4* xr = (const f32x4*)(hin + (size_t)m * DM) + lane;
        f32x4 v[8]; float s = 0.f;
#pragma unroll
        for (int j = 0; j < 8; ++j) { v[j] = xr[64 * j]; s += (v[j].x * v[j].x + v[j].y * v[j].y) + (v[j].z * v[j].z + v[j].w * v[j].w); }
        const float rstd = 1.0f / sqrtf(wave_sum(s) * (1.0f / DM) + EPS);
        const int b = m / SEQ;
#pragma unroll
        for (int j = 0; j < 8; ++j) {
            const int col = 4 * lane + 256 * j;
            const f32x4 gv = *(const f32x4*)(g + col);
            f32x4 y = v[j] * rstd * gv;
            if (FINAL) { *((f32x4*)(fout + (size_t)m * DM + col)) = y; }
            else {
                const f32x4 sh = *(const f32x4*)(mod + (size_t)b * NMOD + col), sc = *(const f32x4*)(mod + (size_t)b * NMOD + DM + col);
                y = y * (sc + 1.0f) + sh;
                v2u o; o.x = pk2(y.x, y.y); o.y = pk2(y.z, y.w);
                *(v2u*)(uout + (size_t)m * DM + col) = o;
            }
        }
    }
}

constexpr int VSTR = 320;
constexpr int KSTR = 272;
constexpr int K64STR = 144;
__device__ __forceinline__ void pv32(f32x16 (&o)[4], const LAS char* vt, bf16x8 pb0, bf16x8 pb1) {
#pragma unroll
    for (int c = 0; c < 4; ++c) {
        const s16x4 l0 = vtr(vt + c * 64), h0 = vtr(vt + 8 * VSTR + c * 64), l1 = vtr(vt + 16 * VSTR + c * 64), h1 = vtr(vt + 24 * VSTR + c * 64);
        const bf16x8 a0 = {l0[0], l0[1], l0[2], l0[3], h0[0], h0[1], h0[2], h0[3]}, a1 = {l1[0], l1[1], l1[2], l1[3], h1[0], h1[1], h1[2], h1[3]};
        o[c] = MFMA32(a0, pb0, o[c]); o[c] = MFMA32(a1, pb1, o[c]);
    }
}
__device__ __forceinline__ void pv32x2(f32x16 (&o1)[4], f32x16 (&o2)[4], const LAS char* vt, bf16x8 p1b0, bf16x8 p1b1, bf16x8 p2b0, bf16x8 p2b1) {
#pragma unroll
    for (int c = 0; c < 4; ++c) {
        const s16x4 l0 = vtr(vt + c * 64), h0 = vtr(vt + 8 * VSTR + c * 64), l1 = vtr(vt + 16 * VSTR + c * 64), h1 = vtr(vt + 24 * VSTR + c * 64);
        const bf16x8 a0 = {l0[0], l0[1], l0[2], l0[3], h0[0], h0[1], h0[2], h0[3]}, a1 = {l1[0], l1[1], l1[2], l1[3], h1[0], h1[1], h1[2], h1[3]};
        o1[c] = MFMA32(a0, p1b0, o1[c]); o1[c] = MFMA32(a1, p1b1, o1[c]);
        o2[c] = MFMA32(a0, p2b0, o2[c]); o2[c] = MFMA32(a1, p2b1, o2[c]);
    }
}

__device__ __forceinline__ void pv32s(f32x16 (&o)[4], const LAS char* vt, int xq, bf16x8 pb0, bf16x8 pb1) {
    __builtin_amdgcn_s_setprio(1);
#pragma unroll
    for (int c = 0; c < 4; ++c) {
        const LAS char* vc = vt + ((64 * c) ^ xq);
        const s16x4 l0 = vtr(vc), h0 = vtr(vc + 8 * 256), l1 = vtr(vc + 16 * 256), h1 = vtr(vc + 24 * 256);
        const bf16x8 a0 = {l0[0], l0[1], l0[2], l0[3], h0[0], h0[1], h0[2], h0[3]}, a1 = {l1[0], l1[1], l1[2], l1[3], h1[0], h1[1], h1[2], h1[3]};
        o[c] = MFMA32(a0, pb0, o[c]); o[c] = MFMA32(a1, pb1, o[c]);
    }
    __builtin_amdgcn_s_setprio(0);
}
__device__ __forceinline__ void pv32x2s(f32x16 (&o1)[4], f32x16 (&o2)[4], const LAS char* vt, int xq, bf16x8 p1b0, bf16x8 p1b1, bf16x8 p2b0, bf16x8 p2b1) {
#pragma unroll
    for (int c = 0; c < 4; ++c) {
        const LAS char* vc = vt + ((64 * c) ^ xq);
        const s16x4 l0 = vtr(vc), h0 = vtr(vc + 8 * 256), l1 = vtr(vc + 16 * 256), h1 = vtr(vc + 24 * 256);
        const bf16x8 a0 = {l0[0], l0[1], l0[2], l0[3], h0[0], h0[1], h0[2], h0[3]}, a1 = {l1[0], l1[1], l1[2], l1[3], h1[0], h1[1], h1[2], h1[3]};
        o1[c] = MFMA32(a0, p1b0, o1[c]); o1[c] = MFMA32(a1, p1b1, o1[c]);
        o2[c] = MFMA32(a0, p2b0, o2[c]); o2[c] = MFMA32(a1, p2b1, o2[c]);
    }
}
__device__ __forceinline__ void glds16(const void* gsrc, unsigned lds_dst) { unsigned keep;
    asm volatile("s_mov_b32 %0, m0\n\ts_mov_b32 m0, %2\n\ts_nop 0\n\tglobal_load_lds_dwordx4 %1, off\n\ts_mov_b32 m0, %0" : "=&s"(keep) : "v"(gsrc), "s"(lds_dst) : "memory"); }
#define GLDS16(gsrc, ldsdst) glds16((const void*)(gsrc), (unsigned)__builtin_amdgcn_readfirstlane((int)(unsigned)(size_t)(ldsdst)))
template <int THR> __device__ __forceinline__ void softmax_block(f32x16& s, float& m, float& l, f32x16 (&o)[4], bf16x8& pb0, bf16x8& pb1) {
    float mx = fmaxf(fmaxf(s[0], s[1]), s[2]);
#pragma unroll
    for (int r = 3; r < 15; r += 2) mx = fmaxf(fmaxf(mx, s[r]), s[r + 1]);
    mx = fmaxf(mx, s[15]);
    mx = xmax(mx);
    if (__any(mx > m + (float)THR)) {
        const float mn = fmaxf(m, mx);
        const float al = __builtin_amdgcn_exp2f(m - mn); l *= al;
#pragma unroll
        for (int c = 0; c < 4; ++c)
#pragma unroll
            for (int r = 0; r < 16; ++r) o[c][r] *= al;
        m = mn;
    }
    float sum = 0.f;
#pragma unroll
    for (int r = 0; r < 16; ++r) { s[r] = __builtin_amdgcn_exp2f(s[r] - m); sum += s[r]; }
    l += sum;
    v4u w0, w1;
    w0.x = cvtpk(s[0], s[1]); w0.y = cvtpk(s[2], s[3]); w0.z = cvtpk(s[4], s[5]); w0.w = cvtpk(s[6], s[7]);
    w1.x = cvtpk(s[8], s[9]); w1.y = cvtpk(s[10], s[11]); w1.z = cvtpk(s[12], s[13]); w1.w = cvtpk(s[14], s[15]);
    pb0 = __builtin_bit_cast(bf16x8, w0); pb1 = __builtin_bit_cast(bf16x8, w1);
}


__device__ __forceinline__ void k_load(const bf16* proj, int tk0, int d, int kcol, int r32, int hi, bf16x8 (&kf)[8]) {
    const int tk = max(tk0 + d * r32, 0); const bf16* kp = proj + (size_t)tk * PINP + kcol + hi * 8;
#pragma unroll
    for (int ss = 0; ss < 8; ++ss) kf[ss] = *(const bf16x8*)(kp + 16 * ss);
}
__device__ __forceinline__ void v_dma(const bf16* proj, int tk0, int d, int vcol, int lane, LAS unsigned char* vbuf) {
    const int c = (lane & 15) ^ (((lane >> 4) & 3) << 2);
#pragma unroll
    for (int i = 0; i < 8; ++i) { const int tk = max(tk0 + d * (4 * i + (lane >> 4)), 0);
        GLDS16(proj + (size_t)tk * PINP + vcol + c * 8, vbuf + i * 1024); }
}

constexpr int DF_TBLN = 1664;
constexpr int DF_TBL = 0, DF_BUF = 6656, DF_BUFB = 32768  , DF_Q = DF_BUF + 2 * DF_BUFB, DF_QW = 32 * KSTR  ;
static_assert(DF_Q + 8 * DF_QW <= LDS_BARST, "diff attention LDS map");
__device__ __forceinline__ void diff_unit(const Args& a, LAS unsigned char* lds, int layer, int bh, int qb) {
    const int tid = opaque_tid(), lane = tid & 63, r32 = lane & 31, hi = lane >> 5, wave = __builtin_amdgcn_readfirstlane(tid >> 6);
    const int b = bh >> 4, h = bh & 15, e = layer >> 1;
    const bf16* proj = (const bf16*)(a.ws + WS_PROJ) + (size_t)b * SEQ * PINP;
    bf16* Gout = (bf16*)(a.ws + WS_G) + (size_t)b * SEQ * DI;
    LAS float* tbl = (LAS float*)(lds + DF_TBL);
    __syncthreads();
    for (int i = tid; i < DF_TBLN; i += 512) { const int rel = i - 64; tbl[i] = rel < 0 ? -INFINITY : a.rel_bias[t5_bucket(rel) * 32 + 16 + h] * LOG2E; }
    const int q0w = qb * 256 + wave * 32;
    LAS unsigned char* qw = lds + DF_Q + wave * DF_QW;
#pragma unroll
    for (int i = 0; i < 8; ++i) { const int idx = lane + 64 * i, row = idx >> 4, ch = idx & 15;
        v4u v = *(const v4u*)(proj + (size_t)(q0w + row) * PINP + (ch < 8 ? 6144 + h * 64 + ch * 8 : 7168 + h * 64 + (ch - 8) * 8));
#pragma unroll
        for (int k = 0; k < 4; ++k) v[k] = cvtpk(bflo(v[k]) * (0.125f * LOG2E), bfhi(v[k]) * (0.125f * LOG2E));
        *(LAS v4u*)(qw + row * KSTR + ch * 16) = v; }
    const int NT = 4 * qb + 4;
    const int kr_ = 8 * wave + (lane >> 3), kc_ = (lane & 7) ^ ((4 * wave + (lane >> 4)) & 7);
    const bf16* k1src = proj + (size_t)kr_ * PINP + 8192 + h * 64 + kc_ * 8;
    const bf16* k2src = proj + (size_t)kr_ * PINP + 9216 + h * 64 + kc_ * 8;
    const int vr_ = 8 * wave + (lane >> 4), vc_ = (lane & 15) ^ (((lane >> 4) & 3) << 2);
    const bf16* vsrc = proj + (size_t)vr_ * PINP + 10240 + h * 128 + vc_ * 8;
#define DF_DMA(t, bufp) do { const size_t o_ = (size_t)(t) * 64 * PINP; LAS unsigned char* b_ = (bufp) + wave * 1024; \
        GLDS16(k1src + o_, b_); GLDS16(k2src + o_, b_ + 8192); GLDS16(vsrc + o_, b_ + 16384 + wave * 1024); GLDS16(vsrc + o_ + (size_t)4 * PINP, b_ + 16384 + wave * 1024 + 1024); } while (0)
    DF_DMA(0, lds + DF_BUF);
    f32x16 o1[4], o2[4];
#pragma unroll
    for (int c = 0; c < 4; ++c) { o1[c] = f32x16{}; o2[c] = f32x16{}; }
    float m1 = -1e30f, l1 = 0.f, m2 = -1e30f, l2 = 0.f;
    const int qpos = q0w + r32;
    const LAS unsigned char* qrd = qw + r32 * KSTR + hi * 16;
    const int kfo = r32 * 128 + (((hi ^ (r32 >> 1)) & 1) * 16), kxt = ((r32 >> 1) & 6) * 16;
    const int vto = (4 * hi + ((lane & 15) >> 2)) * 256 + ((lane >> 4) & 1) * 32 + (lane & 3) * 8, vxq = 64 * ((lane & 15) >> 2);
    asm volatile("s_waitcnt vmcnt(0)" ::: "memory");
    __syncthreads();
    for (int t = 0; t < NT; ++t) {
        LAS unsigned char* buf = lds + DF_BUF + (t & 1) * DF_BUFB;
        if (t + 1 < NT) DF_DMA(t + 1, lds + DF_BUF + ((t + 1) & 1) * DF_BUFB);
#pragma unroll
        for (int half = 0; half < 2; ++half) {
            const int kb = t * 64 + half * 32;
            if (kb > q0w + 31) continue;
            const LAS unsigned char* k1p = buf + half * 32 * 128 + kfo;
            const LAS unsigned char* k2p = k1p + 8192;
            const int rel0 = qpos - kb - 4 * hi;
            const LAS float* tb = tbl + 64 + min(rel0, 1562);
            f32x16 s1, s2;
#pragma unroll
            for (int r = 0; r < 16; ++r) { s1[r] = tb[-((r & 3) + 8 * (r >> 2))]; s2[r] = s1[r]; }
            __builtin_amdgcn_s_setprio(1);
#pragma unroll
            for (int s = 0; s < 4; ++s) s1 = MFMA32(*(const LAS bf16x8*)(k1p + ((32 * s) ^ kxt)), *(const LAS bf16x8*)(qrd + 32 * s), s1);
#pragma unroll
            for (int s = 0; s < 4; ++s) s2 = MFMA32(*(const LAS bf16x8*)(k2p + ((32 * s) ^ kxt)), *(const LAS bf16x8*)(qrd + 128 + 32 * s), s2);
            __builtin_amdgcn_s_setprio(0);
            const LAS char* vt_ = (const LAS char*)(buf + 16384 + half * 32 * 256 + vto);
            { bf16x8 pb0, pb1; softmax_block<8>(s1, m1, l1, o1, pb0, pb1); pv32s(o1, vt_, vxq, pb0, pb1); }
            { bf16x8 pb0, pb1; softmax_block<8>(s2, m2, l2, o2, pb0, pb1); pv32s(o2, vt_, vxq, pb0, pb1); }
        }
        asm volatile("s_waitcnt vmcnt(0)" ::: "memory");
        __syncthreads();
    }
#undef DF_DMA
    float lam;
    { const float* lv = a.diff_lambda + (size_t)e * 256; const float p1 = wave_sum(lv[lane] * lv[64 + lane]), p2 = wave_sum(lv[128 + lane] * lv[192 + lane]);
      lam = __expf(p1) - __expf(p2) + (layer == 0 ? 0.2f : 0.47071302f); }
    const float i1 = 1.0f / xsum(l1), i2 = lam / xsum(l2);
    float ssq = 0.f;
#pragma unroll
    for (int c = 0; c < 4; ++c)
#pragma unroll
        for (int r = 0; r < 16; ++r) { const float v = o1[c][r] * i1 - o2[c][r] * i2; o1[c][r] = v; ssq += v * v; }
    ssq = xsum(ssq);
    const float lam_init = layer == 0 ? 0.2f : 0.47071302f;
    const float rn = (1.0f / sqrtf(ssq * (1.0f / 128.0f) + EPS)) * (1.0f - lam_init);
    const float* sg = a.diff_subln_g + (size_t)e * 128;
    const bf16* zrow = proj + (size_t)qpos * PINP + 12288 + 2048 + h * 128;
    bf16* orow = Gout + (size_t)qpos * DI + 2048 + h * 128;
#pragma unroll
    for (int c = 0; c < 4; ++c)
#pragma unroll
        for (int g4 = 0; g4 < 4; ++g4) {
            const int d0 = 32 * c + 8 * g4 + 4 * hi;
            const v2u zz = *(const v2u*)(zrow + d0); const f32x4 gg = *(const f32x4*)(sg + d0);
            const float y0 = o1[c][4 * g4 + 0] * rn * gg.x * bflo(zz.x), y1 = o1[c][4 * g4 + 1] * rn * gg.y * bfhi(zz.x),
                        y2 = o1[c][4 * g4 + 2] * rn * gg.z * bflo(zz.y), y3 = o1[c][4 * g4 + 3] * rn * gg.w * bfhi(zz.y);
            v2u w; w.x = cvtpk(y0, y1); w.y = cvtpk(y2, y3);
            *(v2u*)(orow + d0) = w;
        }
}

constexpr int DL_TBL = 0  , DL_V = 2048, DL_VW = 16384  ;
static_assert(DL_V + 8 * DL_VW <= LDS_BARST, "dilated attention LDS map");
__device__ __forceinline__ void dilated_unit(const Args& a, LAS unsigned char* lds, int bh, int blk) {
    const int tid = opaque_tid(), lane = tid & 63, r32 = lane & 31, hi = lane >> 5, wave = __builtin_amdgcn_readfirstlane(tid >> 6);
    const int b = bh >> 4, h = bh & 15, Q0 = blk * 512;
    const bf16* proj = (const bf16*)(a.ws + WS_PROJ) + (size_t)b * SEQ * PINP;
    bf16* OG = (bf16*)(a.ws + WS_OG); float* LSE = (float*)(a.ws + WS_LSE);
    LAS float* tbl = (LAS float*)(lds + DL_TBL);
    __syncthreads();
    for (int i = tid; i < 3 * 132; i += 512) { const int g = i / 132, j = i % 132; tbl[i] = a.rel_bias[t5_bucket(j << (2 * g)) * 32 + h] * LOG2E; }
    __syncthreads();
    LAS unsigned char* vw = lds + DL_V + wave * DL_VW;
    const int vto = (4 * hi + ((lane & 15) >> 2)) * 256 + ((lane >> 4) & 1) * 32 + (lane & 3) * 8, vxq = 64 * ((lane & 15) >> 2);
    const float scl = 0.08838834764831845f * LOG2E;
#define DL_GEOM(tau_, G_, D_, TQ0_, KB0_) do { G_ = (tau_) >> 4; const int sub_ = (tau_) & 15, dsh_ = 2 * G_; D_ = 1 << dsh_; const int per_ = 16 >> dsh_; \
        TQ0_ = Q0 + sub_ / per_ + D_ * 32 * (sub_ % per_); KB0_ = 0; while (TQ0_ - 128 * D_ + D_ * 32 * KB0_ + 31 * D_ < 0) ++KB0_; } while (0)
#define DL_QLOAD(TQ0_, D_) do { const bf16* qp_ = proj + (size_t)((TQ0_) + (D_) * r32) * PINP + h * 128 + hi * 8; \
        _Pragma("unroll") for (int s_ = 0; s_ < 8; ++s_) qf[s_] = *(const bf16x8*)(qp_ + 16 * s_); } while (0)
    bf16x8 qf[8], kf[8];
    int tau = wave, g, d, tq0, kb0, par = 0;
    DL_GEOM(tau, g, d, tq0, kb0);
    DL_QLOAD(tq0, d);
    asm volatile("s_waitcnt lgkmcnt(0)" ::: "memory");
    v_dma(proj, tq0 - 128 * d + d * 32 * kb0, d, 4096 + h * 128, lane, vw + par * 8192);
    k_load(proj, tq0 - 128 * d + d * 32 * kb0, d, 2048 + h * 128, r32, hi, kf);
#pragma unroll 1
    for (;;) {
        const int taun = tau + 8; const bool hasn = taun < 48;
        int gn = 0, dn = 1, tq0n = 0, kb0n = 0;
        if (hasn) DL_GEOM(taun, gn, dn, tq0n, kb0n);
        f32x16 o[4];
#pragma unroll
        for (int c = 0; c < 4; ++c) o[c] = f32x16{};
        float m = -1e30f, l = 0.f;
#pragma unroll 1
        for (int kb = kb0; kb < 5; ++kb) {
            const int tk0 = tq0 - 128 * d + d * 32 * kb;
            asm volatile("s_waitcnt vmcnt(0)" ::: "memory");
            f32x16 s = f32x16{};
#pragma unroll
            for (int ss = 0; ss < 8; ++ss) s = MFMA32(kf[ss], qf[ss], s);
            int ntk0 = tk0 + d * 32, nd = d; bool pf = kb < 4;
            if (!pf && hasn) { ntk0 = tq0n - 128 * dn + dn * 32 * kb0n; nd = dn; pf = true; DL_QLOAD(tq0n, dn); }
            if (pf) { v_dma(proj, ntk0, nd, 4096 + h * 128, lane, vw + (par ^ 1) * 8192); k_load(proj, ntk0, nd, 2048 + h * 128, r32, hi, kf); }
            const int j0 = r32 + 128 - 32 * kb - 4 * hi;
#pragma unroll
            for (int r = 0; r < 16; ++r) {
                const int kk = (r & 3) + 8 * (r >> 2); const int j = j0 - kk;
                const bool valid = (j >= 0) && (j <= 128) && (tk0 + d * (kk + 4 * hi) >= 0);
                const float bv = tbl[g * 132 + min(max(j, 0), 128)];
                s[r] = valid ? s[r] * scl + bv : -INFINITY;
            }
            bf16x8 pb0, pb1;
            softmax_block<8>(s, m, l, o, pb0, pb1);
            pv32s(o, (const LAS char*)(vw + par * 8192 + vto), vxq, pb0, pb1);
            par ^= 1;
        }
        const float lt = xsum(l); const float il = 1.0f / lt;
        const int tq = tq0 + d * r32;
        bf16* orow = OG + ((size_t)g * MTOK + (size_t)b * SEQ + tq) * DM + h * 128;
#pragma unroll
        for (int c = 0; c < 4; ++c)
#pragma unroll
            for (int g4 = 0; g4 < 4; ++g4) {
                v2u w; w.x = cvtpk(o[c][4 * g4] * il, o[c][4 * g4 + 1] * il); w.y = cvtpk(o[c][4 * g4 + 2] * il, o[c][4 * g4 + 3] * il);
                *(v2u*)(orow + 32 * c + 8 * g4 + 4 * hi) = w;
            }
        if (hi == 0) LSE[((size_t)g * MTOK + (size_t)b * SEQ + tq) * 16 + h] = (m + __builtin_amdgcn_logf(lt)) * LN2;
        if (!hasn) break;
        tau = taun; g = gn; d = dn; tq0 = tq0n; kb0 = kb0n;
    }
#undef DL_GEOM
#undef DL_QLOAD
    asm volatile("s_waitcnt vmcnt(0)" ::: "memory");
    __threadfence_block();
    __syncthreads();
    bf16* Gout = (bf16*)(a.ws + WS_G) + (size_t)b * SEQ * DI;
    for (int p0 = 0; p0 < 16; p0 += 4) {
        const int ch = tid & 15;
        float e0[4], e1[4], e2[4]; v4u a0[4], a1[4], a2[4], zz[4];
#pragma unroll
        for (int u = 0; u < 4; ++u) {
            const int tq = Q0 + (p0 + u) * 32 + (tid >> 4); const size_t tok = (size_t)b * SEQ + tq;
            e0[u] = LSE[((size_t)0 * MTOK + tok) * 16 + h]; e1[u] = LSE[((size_t)1 * MTOK + tok) * 16 + h]; e2[u] = LSE[((size_t)2 * MTOK + tok) * 16 + h];
            a0[u] = *(const v4u*)(OG + ((size_t)0 * MTOK + tok) * DM + h * 128 + ch * 8); a1[u] = *(const v4u*)(OG + ((size_t)1 * MTOK + tok) * DM + h * 128 + ch * 8);
            a2[u] = *(const v4u*)(OG + ((size_t)2 * MTOK + tok) * DM + h * 128 + ch * 8);
            zz[u] = *(const v4u*)(proj + (size_t)tq * PINP + 12288 + h * 128 + ch * 8);
        }
#pragma unroll
        for (int u = 0; u < 4; ++u) {
            const int tq = Q0 + (p0 + u) * 32 + (tid >> 4);
            const float mx = fmaxf(e0[u], fmaxf(e1[u], e2[u])); float w0 = __expf(e0[u] - mx), w1 = __expf(e1[u] - mx), w2 = __expf(e2[u] - mx);
            const float inv = 1.0f / (w0 + w1 + w2); w0 *= inv; w1 *= inv; w2 *= inv;
            v4u w;
#pragma unroll
            for (int k = 0; k < 4; ++k) {
                const float lo = (w0 * bflo(a0[u][k]) + w1 * bflo(a1[u][k]) + w2 * bflo(a2[u][k])) * bflo(zz[u][k]);
                const float hh = (w0 * bfhi(a0[u][k]) + w1 * bfhi(a1[u][k]) + w2 * bfhi(a2[u][k])) * bfhi(zz[u][k]);
                w[k] = cvtpk(lo, hh);
            }
            *(v4u*)(Gout + (size_t)tq * DI + h * 128 + ch * 8) = w;
        }
    }
}

constexpr int SK_SLOT = 16384, SK_NSLOT = 9, SK_FLAG = SK_NSLOT * SK_SLOT;
static_assert(SK_FLAG + 64 <= LDS_BARST, "stick-breaking LDS map");
__device__ __forceinline__ void stick_unit(const Args& a, LAS unsigned char* lds, int bh, int qb) {
    const int tid = opaque_tid(), lane = tid & 63, r32 = lane & 31, hi = lane >> 5, wave = __builtin_amdgcn_readfirstlane(tid >> 6);
    const int b = bh >> 5, h = bh & 31;
    const bf16* proj = (const bf16*)(a.ws + WS_PROJ) + (size_t)b * SEQ * PINP;
    bf16* Gout = (bf16*)(a.ws + WS_G) + (size_t)b * SEQ * DI;
    LAS unsigned* flags = (LAS unsigned*)(lds + SK_FLAG);
    const int Q0 = qb * 256, q0w = Q0 + wave * 32, qpos = q0w + r32;
    bf16x8 qf[8];
    { const bf16* qp = proj + (size_t)qpos * PINP + h * 128 + hi * 8;
#pragma unroll
      for (int s = 0; s < 8; ++s) qf[s] = *(const bf16x8*)(qp + 16 * s); }
    v2u zz[16];
    { const bf16* zrow = proj + (size_t)qpos * PINP + 12288 + h * 128 + 4 * hi;
#pragma unroll
      for (int i = 0; i < 16; ++i) zz[i] = *(const v2u*)(zrow + 32 * (i >> 2) + 8 * (i & 3)); }
    const int drow = 4 * wave + (lane >> 4);
    const bf16* ksrc = proj + (size_t)drow * PINP + 4096 + h * 128 + (((lane & 15) ^ (drow & 15)) * 8);
    const bf16* vsrc = proj + (size_t)drow * PINP + 8192 + h * 128 + (((lane & 15) ^ (((lane >> 4) & 3) << 2)) * 8);
#define SK_DMA(y) do { const int kb_ = Q0 + 224 - 32 * (y); if (kb_ >= 0) { LAS unsigned char* sl_ = lds + ((y) % SK_NSLOT) * SK_SLOT + wave * 1024; \
        GLDS16(ksrc + (size_t)kb_ * PINP, sl_); GLDS16(vsrc + (size_t)kb_ * PINP, sl_ + 8192); } } while (0)
    __syncthreads();
#pragma unroll 1
    for (int y = 0; y < 8; ++y) SK_DMA(y);
    f32x16 o[4];
#pragma unroll
    for (int c = 0; c < 4; ++c) o[c] = f32x16{};
    float R = 0.f;
    const float scl = 0.08838834764831845f;
    const int kfo = r32 * 256 + (((hi ^ r32) & 1) * 16), kxt = (r32 & 14) * 16;
    const int vto = (4 * hi + ((lane & 15) >> 2)) * 256 + ((lane >> 4) & 1) * 32 + (lane & 3) * 8, vxq = 64 * ((lane & 15) >> 2);
#pragma unroll
    for (int i = 0; i < 16; ++i) asm volatile("" : "+v"(zz[i]));
#pragma unroll 1
    for (int j = 0;; ++j) {
        asm volatile("s_waitcnt vmcnt(0)" ::: "memory");
        __syncthreads();
        if (j > 0) { unsigned alld = 1u;
#pragma unroll
            for (int w = 0; w < 8; ++w) alld &= flags[((j - 1) & 1) * 8 + w];
            if (alld) break; }
        SK_DMA(8 + j);
        const int kb = q0w - 32 * j;
        if (kb >= 0 && !__all(R < -40.0f)) {
            const LAS unsigned char* slot = lds + ((7 - wave + j) % SK_NSLOT) * SK_SLOT;
            f32x16 s = f32x16{};
#pragma unroll
            for (int ss = 0; ss < 8; ++ss) s = MFMA32(*(const LAS bf16x8*)(slot + kfo + ((32 * ss) ^ kxt)), qf[ss], s);
            const bool diag = j == 0;
            const int rel0 = qpos - kb - 4 * hi;
            f32x16 lb;
#pragma unroll
            for (int r = 0; r < 16; ++r) {
                const float z = s[r] * scl;
                const float sp = fmaxf(z, 0.f) + __builtin_amdgcn_logf(1.0f + __builtin_amdgcn_exp2f(-fabsf(z) * LOG2E)) * LN2;
                const bool valid = !diag || (rel0 - ((r & 3) + 8 * (r >> 2)) > 0);
                s[r] = valid ? -sp : 0.f;
                lb[r] = valid ? z - sp : -INFINITY;
            }
            float gs[4], ps[4], E[4];
#pragma unroll
            for (int g = 0; g < 4; ++g) { gs[g] = (s[4 * g] + s[4 * g + 1]) + (s[4 * g + 2] + s[4 * g + 3]); ps[g] = xpartner(gs[g], hi); }
            float run = 0.f;
#pragma unroll
            for (int g = 3; g >= 0; --g) { E[g] = run + (hi == 0 ? ps[g] : 0.f); run += gs[g] + ps[g]; }
#pragma unroll
            for (int g = 0; g < 4; ++g) {
                const float base = R + E[g];
                const float t3 = base, t2 = t3 + s[4 * g + 3], t1 = t2 + s[4 * g + 2], t0 = t1 + s[4 * g + 1];
                s[4 * g + 3] = __builtin_amdgcn_exp2f((lb[4 * g + 3] + t3) * LOG2E); s[4 * g + 2] = __builtin_amdgcn_exp2f((lb[4 * g + 2] + t2) * LOG2E);
                s[4 * g + 1] = __builtin_amdgcn_exp2f((lb[4 * g + 1] + t1) * LOG2E); s[4 * g + 0] = __builtin_amdgcn_exp2f((lb[4 * g + 0] + t0) * LOG2E);
            }
            R += run;
            v4u w0, w1;
            w0.x = cvtpk(s[0], s[1]); w0.y = cvtpk(s[2], s[3]); w0.z = cvtpk(s[4], s[5]); w0.w = cvtpk(s[6], s[7]);
            w1.x = cvtpk(s[8], s[9]); w1.y = cvtpk(s[10], s[11]); w1.z = cvtpk(s[12], s[13]); w1.w = cvtpk(s[14], s[15]);
            pv32s(o, (const LAS char*)(slot + 8192 + vto), vxq, __builtin_bit_cast(bf16x8, w0), __builtin_bit_cast(bf16x8, w1));
        }
        if (lane == 0) flags[(j & 1) * 8 + wave] = (kb - 32 < 0 || __all(R < -40.0f)) ? 1u : 0u;
    }
#undef SK_DMA
    bf16* orow = Gout + (size_t)qpos * DI + h * 128;
#pragma unroll
    for (int c = 0; c < 4; ++c)
#pragma unroll
        for (int g4 = 0; g4 < 4; ++g4) {
            const int d0 = 32 * c + 8 * g4 + 4 * hi;
            const v2u z2 = zz[c * 4 + g4];
            v2u w; w.x = cvtpk(o[c][4 * g4 + 0] * bflo(z2.x), o[c][4 * g4 + 1] * bfhi(z2.x)); w.y = cvtpk(o[c][4 * g4 + 2] * bflo(z2.y), o[c][4 * g4 + 3] * bfhi(z2.y));
            *(v2u*)(orow + d0) = w;
        }
}

#define XB_TMO      128
#define XB_XCNT(j)  (256  + 64 * (j))
#define XB_XSUB(j)  (1280 + 64 * (j))
#define XB_XGEN(j)  (2304 + 64 * (j))
#define XB_TOP      3328
#define XB_TOPGEN   3392
#define XCD_BAR_WORDS 3456
#define XB_SPIN_CAP (1u << 18)

__device__ __forceinline__ unsigned xb_ld(unsigned* p)              { return __hip_atomic_load(p, __ATOMIC_RELAXED, __HIP_MEMORY_SCOPE_AGENT); }
__device__ __forceinline__ unsigned xb_add(unsigned* p, unsigned v) { return __hip_atomic_fetch_add(p, v, __ATOMIC_RELAXED, __HIP_MEMORY_SCOPE_AGENT); }
__device__ __forceinline__ unsigned xb_xcc_id() { return (unsigned)__builtin_amdgcn_s_getreg((3 << 11) | 20) & 0xFu; }
#define XB_SPIN(cond, bar) do { unsigned _sp = 0; while (cond) { __builtin_amdgcn_s_sleep(1); \
    if ((++_sp & 255u) == 0u) { if (xb_ld(&(bar)[XB_TMO])) break; if (_sp > XB_SPIN_CAP) { atomicAdd(&(bar)[XB_TMO], 1u); break; } } } } while (0)

struct XcdBarrier {
    unsigned* bar; unsigned x;
    volatile LAS unsigned* st;
};

__device__ __forceinline__ XcdBarrier xcd_barrier_post(unsigned* bar, volatile LAS unsigned* st) {
    XcdBarrier b; b.bar = bar; b.x = xb_xcc_id(); b.st = st;
    if (threadIdx.x == 0) (void)xb_add(&bar[XB_XCNT(b.x)], 1u);
    return b;
}
__device__ __forceinline__ void xcd_barrier_complete(unsigned* bar, unsigned x, unsigned& nloc, unsigned& nx) {
    const unsigned G = gridDim.x * gridDim.y * gridDim.z;
    unsigned sum, cnt, mine, sp = 0u;
    for (;;) {
        sum = 0u; cnt = 0u; mine = 0u;
#pragma unroll
        for (unsigned j = 0; j < 16; ++j) { const unsigned c = xb_ld(&bar[XB_XCNT(j)]); sum += c; cnt += (c > 0u) ? 1u : 0u; mine = (j == x) ? c : mine; }
        if (sum == G) break;
        __builtin_amdgcn_s_sleep(1);
        if ((++sp & 255u) == 0u) { if (xb_ld(&bar[XB_TMO])) break; if (sp > XB_SPIN_CAP) { atomicAdd(&bar[XB_TMO], 1u); break; } }
    }
    nloc = mine > 0u ? mine : 1u; nx = cnt > 0u ? cnt : 1u;
}

__device__ __forceinline__ void xcd_barrier(const XcdBarrier& b) {
    asm volatile("s_waitcnt vmcnt(0)" ::: "memory");
    __syncthreads();
    if (threadIdx.x == 0) {
        unsigned* bar = b.bar;
        __builtin_amdgcn_s_waitcnt(0);
        unsigned nloc = b.st[0], nx = b.st[1];
        if (nloc == 0u) { xcd_barrier_complete(bar, b.x, nloc, nx); b.st[0] = nloc; b.st[1] = nx; }
        const unsigned old = xb_add(&bar[XB_XSUB(b.x)], 1u);
        const unsigned gen = old / nloc;
        if (old + 1u == (gen + 1u) * nloc) {
            __builtin_amdgcn_fence(__ATOMIC_RELEASE, "agent");
            asm volatile("s_waitcnt vmcnt(0)" ::: "memory");
            const unsigned og = xb_add(&bar[XB_TOP], 1u);
            const unsigned tg = og / nx;
            if (og + 1u == (tg + 1u) * nx) xb_add(&bar[XB_TOPGEN], 1u);
            else XB_SPIN(xb_ld(&bar[XB_TOPGEN]) == tg, bar);
            __builtin_amdgcn_fence(__ATOMIC_ACQUIRE, "agent");
            xb_add(&bar[XB_XGEN(b.x)], 1u);
            asm volatile("s_waitcnt vmcnt(0)" ::: "memory");
        } else {
            XB_SPIN(xb_ld(&bar[XB_XGEN(b.x)]) == gen, bar);
            __builtin_amdgcn_fence(__ATOMIC_ACQUIRE, "agent");
            asm volatile("s_waitcnt vmcnt(0)" ::: "memory");
        }
    }
    __syncthreads();
}

__global__ void __launch_bounds__(512, 2) trunk_fwd(Args a) {
    extern __shared__ __attribute__((aligned(16))) unsigned char smem[];
    LAS unsigned char* lds = (LAS unsigned char*)smem;
    cg::grid_group grid = cg::this_grid();
    const int G = gridDim.x, bx = blockIdx.x;
    const int vcu = (G % 8 == 0) ? (bx % 8) * (G / 8) + bx / 8 : bx;
    unsigned char* ws = a.ws;
    float* H = (float*)(ws + WS_H);
    bf16* U = (bf16*)(ws + WS_U);
    bf16* PROJ = (bf16*)(ws + WS_PROJ);
    bf16* GB = (bf16*)(ws + WS_G);

    unsigned* barw = (unsigned*)(ws + WS_BAR);
    if (bx == 0) for (int i = threadIdx.x; i < CW_WORDS; i += 512) __hip_atomic_store(barw + i, 0u, __ATOMIC_RELAXED, __HIP_MEMORY_SCOPE_AGENT);
    volatile LAS unsigned* barst = (volatile LAS unsigned*)(lds + LDS_BARST);
    if (threadIdx.x < 2) barst[threadIdx.x] = 0u;
    p0_prologue(a, lds, G);
#if PROBE == 1
    __syncthreads(); p0_prologue(a, lds, G);
#endif
    __syncthreads();
    grid.sync();
    const XcdBarrier xbar = xcd_barrier_post(barw, barst);
#define GRID_SYNC() xcd_barrier(xbar)
    const bool fusedn = (G == 256);
#pragma unroll 1
    for (int layer = 0; layer < DEPTH; ++layer) {
        const float* hin = layer == 0 ? a.x : H;
        const float* mod = (const float*)(ws + WS_MOD) + (size_t)layer * NB * NMOD;
        if (layer == 0 || !fusedn) {
            rows_phase<false>(hin, a.norm_g + (size_t)layer * DM, mod, U, nullptr, G);
            GRID_SYNC();
        }
        {
            pg8::Gemm g{U, (const bf16*)(ws + WS_WIN) + (size_t)layer * PIN * DM, MTOK, PIN, DM};
            pg8::StaticOrder S; S.init(MTOK, PIN, G, bx);
            pg8::EpiProj E{PROJ, PINP, 48};
            pg8::gemm_phase<pg8::EpiProj, pg8::StaticOrder, false, true>(lds, g, S, E);
#if PROBE == 2
            __syncthreads(); pg8::gemm_phase<pg8::EpiProj, pg8::StaticOrder, false, true>(lds, g, S, E);
#endif
        }
        GRID_SYNC();
        for (int rep_ = 0; rep_ < ((PROBE == 3 && (layer & 1) == 0) || (PROBE == 4 && (layer & 1) == 1) ? 2 : 1); ++rep_)
        if ((layer & 1) == 0) {
#pragma unroll 1
            for (int pass = 0; pass < 2; ++pass) {
                if (((pass ^ (vcu >> 7)) & 1) == 0) { for (int u = vcu; u < 256; u += G) dilated_unit(a, lds, u >> 3, u & 7); }
                else { for (int p = vcu; p < 256; p += G) { diff_unit(a, lds, layer, p >> 3, p & 7); diff_unit(a, lds, layer, p >> 3, 15 - (p & 7)); } }
            }
        } else {
            for (int u = vcu; u < 1024; u += G) stick_unit(a, lds, u >> 4, u & 15);
        }
        __syncthreads();
        GRID_SYNC();
        {
            pg8::Gemm g{GB, (const bf16*)(ws + WS_WOUT) + (size_t)layer * DM * DI, MTOK, DM, DI};
            pg8::StaticOrder S; S.init(MTOK, DM, G, bx);
            if (fusedn) {
                const bool fin = layer == DEPTH - 1;
                pg8::EpiResNorm E{hin, H, mod + 2 * DM, DM, NMOD, SEQ, fin ? a.final_norm_g : a.norm_g + (size_t)(layer + 1) * DM, fin ? nullptr : mod + NB * NMOD, U, a.out,
                                  (float*)(ws + WS_SLOTS), barw + CW_PANEL + layer * 32 * 64, fin ? 1 : 0};
                pg8::gemm_phase<pg8::EpiResNorm, pg8::StaticOrder, false, true>(lds, g, S, E);
            } else {
                pg8::EpiRes E{hin, H, mod + 2 * DM, DM, NMOD, SEQ};
                pg8::gemm_phase<pg8::EpiRes, pg8::StaticOrder, true, true>(lds, g, S, E);
            }
        }
        if (layer + 1 < DEPTH || !fusedn) GRID_SYNC();
    }
    if (!fusedn) rows_phase<true>(H, a.final_norm_g, nullptr, nullptr, a.out, G);
}

extern "C" void kernel_launch(void* const* d_in, const int* in_sizes, int n_in, void* d_out, int out_size, void* d_ws, size_t ws_size, hipStream_t stream) {
    static int grid = 0;
    if (grid == 0) {
        if (n_in != 11 || out_size != MTOK * DM || ws_size < WS_END) { fprintf(stderr, "kernel_launch: unexpected shapes (n_in %d out %d ws %zu)\n", n_in, out_size, ws_size); grid = -1; return; }
        int dev = 0, cus = 0, per_cu = 0;
        (void)hipGetDevice(&dev);
        (void)hipDeviceGetAttribute(&cus, hipDeviceAttributeMultiprocessorCount, dev);
        (void)hipFuncSetAttribute((const void*)trunk_fwd, hipFuncAttributeMaxDynamicSharedMemorySize, LDS_BYTES);
        if (hipOccupancyMaxActiveBlocksPerMultiprocessor(&per_cu, (const void*)trunk_fwd, 512, LDS_BYTES) != hipSuccess || per_cu < 1) { fprintf(stderr, "kernel_launch: occupancy query says %d\n", per_cu); per_cu = 1; }
        (void)hipGetLastError();
        grid = cus * per_cu;
    }
    if (grid < 0) return;
    Args a{};
    a.x = (const float*)d_in[0]; a.c = (const float*)d_in[1]; a.norm_g = (const float*)d_in[2]; a.w_mod = (const float*)d_in[3]; a.b_mod = (const float*)d_in[4];
    a.w_in = (const float*)d_in[5]; a.w_out = (const float*)d_in[6]; a.rel_bias = (const float*)d_in[7]; a.diff_lambda = (const float*)d_in[8];
    a.diff_subln_g = (const float*)d_in[9]; a.final_norm_g = (const float*)d_in[10]; a.out = (float*)d_out; a.ws = (unsigned char*)d_ws;
    void* args[] = {&a};
    hipError_t e = hipLaunchCooperativeKernel((const void*)trunk_fwd, dim3(grid), dim3(512), args, LDS_BYTES, stream);
    if (e != hipSuccess) fprintf(stderr, "cooperative launch failed: %s (grid %d)\n", hipGetErrorString(e), grid);
}
```

```cpp
#include <hip/hip_runtime.h>
#include <hip/hip_cooperative_groups.h>
#include <cstdio>
#include <cstdint>
namespace cg = cooperative_groups;
#ifndef PROBE
#define PROBE 0
#endif
namespace pg8 {
#define PG8_LAS __attribute__((address_space(3)))
typedef unsigned short bf16_t;
typedef short bf16x8 __attribute__((ext_vector_type(8)));
typedef float f32x4 __attribute__((ext_vector_type(4)));
typedef unsigned u32x4 __attribute__((ext_vector_type(4)));
constexpr int BM = 256, BK = 64, HALF = 128, HTB = HALF * BK * 2  , STAGE_BYTES = 8 * HTB, NXCD = 8, WGM = 4;

__host__ __device__ __forceinline__ int lds_byte(int r, int c) { const int st = (r >> 4) * 2 + (c >> 5), rr = r & 15, cc = c & 31, ob = rr * 64 + cc * 2; return st * 1024 + (ob ^ (((ob >> 9) & 1) << 5)); }
__host__ __device__ __forceinline__ void stage_rc(int b, int& R, int& C) { const int st = b / 1024, sb = b % 1024, swz = sb ^ (((sb >> 9) & 1) << 5); R = (st >> 1) * 16 + swz / 64; C = (st & 1) * 32 + (swz % 64) / 2; }
__host__ __device__ __forceinline__ int perm32(int rho) { const int n = rho >> 4, i = rho & 15; return 8 * (i >> 2) + 4 * n + (i & 3); }

struct Unit { int pm, pn; };
struct Gemm { const bf16_t* A; const bf16_t* Bt; int M, N, K; };

struct StaticOrder {
    int nM, nN, nwg, G, c;
    __host__ __device__ void init(int M, int N, int G_, int c_) { nM = M / BM; nN = N / BM; nwg = nM * nN; G = G_; c = c_; }
    __host__ __device__ bool next(int i, Unit& u) const {
        const long L = (long)i * G + c; if (L >= nwg) return false;
        int wgid = (int)L; { const int q = nwg / NXCD, r = nwg % NXCD, xcd = wgid % NXCD, off = wgid / NXCD; wgid = (xcd < r ? xcd * (q + 1) : r * (q + 1) + (xcd - r) * q) + off; }
        const int nig = WGM * nN, gid = wgid / nig, fm = gid * WGM, gsz = (nM - fm) < WGM ? (nM - fm) : WGM;
        u.pm = fm + ((wgid % nig) % gsz); u.pn = (wgid % nig) / gsz; return true;
    }
    __device__ __forceinline__ void a_ready(const Unit&) const {}
    __device__ __forceinline__ void done(const Unit&) const {}
};

__device__ __forceinline__ unsigned cvt_pk_bf16(float lo, float hi) { unsigned r; asm volatile("v_cvt_pk_bf16_f32 %0, %1, %2" : "=v"(r) : "v"(lo), "v"(hi)); return r; }
typedef float f32x2 __attribute__((ext_vector_type(2)));

__device__ __forceinline__ float silu_f(float v) { return v * __builtin_amdgcn_rcpf(1.0f + __builtin_amdgcn_exp2f(v * -1.4426950408889634f)); }
struct EpiProj {
    static constexpr bool PERM = true, AFTER_DRAIN = false;
    bf16_t* O; int ldc; int act_pn0;
    __device__ __forceinline__ void operator()(const f32x4 (&acc)[2][2][4][2], const Unit& u, int wr, int wc, int fr, int fq) const {
        const int row0 = u.pm * BM + wr * 64 + fr; const int col0 = u.pn * BM + wc * 32 + 8 * fq;
        const bool act = u.pn >= act_pn0;
#pragma unroll
        for (int ai = 0; ai < 2; ++ai)
#pragma unroll
            for (int m = 0; m < 4; ++m) { bf16_t* rowp = O + (size_t)(row0 + ai * HALF + m * 16) * ldc + col0;
#pragma unroll
                for (int bj = 0; bj < 2; ++bj) { f32x4 v0 = acc[ai][bj][m][0], v1 = acc[ai][bj][m][1];
                    if (act) { v0 = (f32x4){silu_f(v0[0]), silu_f(v0[1]), silu_f(v0[2]), silu_f(v0[3])}; v1 = (f32x4){silu_f(v1[0]), silu_f(v1[1]), silu_f(v1[2]), silu_f(v1[3])}; }
                    u32x4 w; w.x = cvt_pk_bf16(v0[0], v0[1]); w.y = cvt_pk_bf16(v0[2], v0[3]); w.z = cvt_pk_bf16(v1[0], v1[1]); w.w = cvt_pk_bf16(v1[2], v1[3]);
                    *(u32x4*)(rowp + bj * HALF) = w; } }
    }
};
struct EpiRes {
    static constexpr bool PERM = false, AFTER_DRAIN = false;
    const float* hin; float* hout; const float* gate; int ldc; int gate_bstride; int rows_per_batch;
    __device__ __forceinline__ void operator()(const f32x4 (&acc)[2][2][4][2], const Unit& u, int wr, int wc, int fr, int fq) const {
        const int col0 = u.pn * BM + wc * 32 + 4 * fq; const int b = (u.pm * BM) / rows_per_batch;
        const float* gp = gate + (size_t)b * gate_bstride + col0;
#pragma unroll
        for (int bj = 0; bj < 2; ++bj)
#pragma unroll
            for (int n = 0; n < 2; ++n) { const f32x4 gv = *(const f32x4*)(gp + bj * HALF + n * 16);
#pragma unroll
                for (int ai = 0; ai < 2; ++ai)
#pragma unroll
                    for (int m = 0; m < 4; ++m) { const size_t off = (size_t)(u.pm * BM + ai * HALF + wr * 64 + m * 16 + fr) * ldc + col0 + bj * HALF + n * 16;
                        const f32x4 hv = *(const f32x4*)(hin + off); *(f32x4*)(hout + off) = hv + gv * acc[ai][bj][m][n]; } }
    }
};

struct EpiResNorm {
    static constexpr bool PERM = false, AFTER_DRAIN = true;
    const float* hin; float* hout; const float* gate; int ldc; int gate_bstride; int rows_per_batch;
    const float* ng; const float* nmod; bf16_t* uout; float* fout; float* slots; unsigned* cnt; int final_;
    __device__ __forceinline__ void fused(f32x4 (&acc)[2][2][4][2], const Unit& u, int wr, int wc, int fr, int fq, PG8_LAS unsigned char* lds, int wid, int lane) const {
        const int tid = wid * 64 + lane;
        const int col0 = u.pn * BM + wc * 32 + 4 * fq; const int b = (u.pm * BM) / rows_per_batch;
        const float* gp = gate + (size_t)b * gate_bstride + col0;
        PG8_LAS float* P = (PG8_LAS float*)lds;
        PG8_LAS float* S = (PG8_LAS float*)(lds + 4096);
#pragma unroll
        for (int bj = 0; bj < 2; ++bj)
#pragma unroll
            for (int n = 0; n < 2; ++n) { const f32x4 gv = *(const f32x4*)(gp + bj * HALF + n * 16);
#pragma unroll
                for (int ai = 0; ai < 2; ++ai)
#pragma unroll
                    for (int m = 0; m < 4; ++m) { const size_t off = (size_t)(u.pm * BM + ai * HALF + wr * 64 + m * 16 + fr) * ldc + col0 + bj * HALF + n * 16;
                        const f32x4 hv = *(const f32x4*)(hin + off) + gv * acc[ai][bj][m][n]; acc[ai][bj][m][n] = hv;
                        if (!final_) *(f32x4*)(hout + off) = hv; } }
#pragma unroll
        for (int ai = 0; ai < 2; ++ai)
#pragma unroll
            for (int m = 0; m < 4; ++m) { float q = 0.f;
#pragma unroll
                for (int bj = 0; bj < 2; ++bj)
#pragma unroll
                    for (int n = 0; n < 2; ++n) { const f32x4 x = acc[ai][bj][m][n]; q += (x[0] * x[0] + x[1] * x[1]) + (x[2] * x[2] + x[3] * x[3]); }
                q += __shfl_xor(q, 16); q += __shfl_xor(q, 32);
                if (fq == 0) P[(ai * HALF + wr * 64 + m * 16 + fr) * 4 + wc] = q; }
        asm volatile("s_waitcnt lgkmcnt(0)" ::: "memory"); __builtin_amdgcn_s_barrier(); asm volatile("" ::: "memory");
        if (tid < BM) { const float t = (P[tid * 4 + 0] + P[tid * 4 + 1]) + (P[tid * 4 + 2] + P[tid * 4 + 3]);
            __hip_atomic_store(slots + (size_t)(u.pm * BM + tid) * 8 + u.pn, t, __ATOMIC_RELAXED, __HIP_MEMORY_SCOPE_AGENT); }
        asm volatile("s_waitcnt vmcnt(0)" ::: "memory"); __builtin_amdgcn_s_barrier(); asm volatile("" ::: "memory");
        if (tid == 0) { __hip_atomic_fetch_add(cnt + 64 * u.pm, 1u, __ATOMIC_RELAXED, __HIP_MEMORY_SCOPE_AGENT);
            unsigned spins = 0u;
            while (__hip_atomic_load(cnt + 64 * u.pm, __ATOMIC_RELAXED, __HIP_MEMORY_SCOPE_AGENT) < 8u) { __builtin_amdgcn_s_sleep(2); if (++spins > (1u << 22)) break; }
            __builtin_amdgcn_fence(__ATOMIC_ACQUIRE, "agent"); }
        asm volatile("s_waitcnt vmcnt(0) lgkmcnt(0)" ::: "memory"); __builtin_amdgcn_s_barrier(); asm volatile("" ::: "memory");
        if (tid < BM) { const float* sl = slots + (size_t)(u.pm * BM + tid) * 8; float t = 0.f;
#pragma unroll
            for (int k = 0; k < 8; ++k) t += __hip_atomic_load(sl + k, __ATOMIC_RELAXED, __HIP_MEMORY_SCOPE_AGENT);
            S[tid] = 1.0f / sqrtf(t * (1.0f / 2048.0f) + 1e-6f); }
        asm volatile("s_waitcnt vmcnt(0) lgkmcnt(0)" ::: "memory"); __builtin_amdgcn_s_barrier(); asm volatile("" ::: "memory");
#pragma unroll
        for (int bj = 0; bj < 2; ++bj)
#pragma unroll
            for (int n = 0; n < 2; ++n) { const int c = col0 + bj * HALF + n * 16; const f32x4 g4 = *(const f32x4*)(ng + c);
                f32x4 sc4 = {0.f, 0.f, 0.f, 0.f}, sh4 = {0.f, 0.f, 0.f, 0.f};
                if (!final_) { sh4 = *(const f32x4*)(nmod + (size_t)b * gate_bstride + c); sc4 = *(const f32x4*)(nmod + (size_t)b * gate_bstride + 2048 + c); }
#pragma unroll
                for (int ai = 0; ai < 2; ++ai)
#pragma unroll
                    for (int m = 0; m < 4; ++m) { const int r = ai * HALF + wr * 64 + m * 16 + fr; const float rs = S[r]; const size_t off = (size_t)(u.pm * BM + r) * ldc + c;
                        f32x4 y = acc[ai][bj][m][n] * rs * g4;
                        if (final_) *(f32x4*)(fout + off) = y;
                        else { y = y * (sc4 + 1.0f) + sh4; typedef unsigned u32x2_ __attribute__((ext_vector_type(2))); u32x2_ w; w.x = cvt_pk_bf16(y[0], y[1]); w.y = cvt_pk_bf16(y[2], y[3]); *(u32x2_*)(uout + off) = w; } } }
    }
};
template <class Epi, class Sched, bool ALIGN_EPI = false, bool SP2 = false>
__device__ __forceinline__ void gemm_phase(PG8_LAS unsigned char* lds, const Gemm g, const Sched& S, const Epi& E) {
    int tid0_ = threadIdx.x; asm volatile("" : "+v"(tid0_));
    const int tid = tid0_, wid = __builtin_amdgcn_readfirstlane(tid >> 6), lane = tid & 63, wr = wid >> 2, wc = wid & 3, fr = lane & 15, fq = lane >> 4;
    const int K = g.K, nt = K / BK;
    unsigned voffA[2], voffB[2];
#pragma unroll
    for (int i = 0; i < 2; ++i) { int R, C; stage_rc(tid * 16 + i * 8192, R, C); const int Rb = Epi::PERM ? ((R & ~31) + perm32(R & 31)) : R;
        voffA[i] = (unsigned)(R * K + C) * 2u; voffB[i] = (unsigned)(Rb * K + C) * 2u; }
    const size_t kstep = (size_t)(BK * 2);
    const size_t hstep = (size_t)HALF * K * 2;
    const size_t tstep = 2 * hstep;
    const unsigned ldsw = (unsigned)wid * 1024u;
    const int aoff = lds_byte(wr * 64 + fr, fq * 8), boff = lds_byte(wc * 32 + fr, fq * 8);
#define PG8_SA(b, h) (((b) * 2 + (h)) * HTB)
#define PG8_SB(b, h) ((4 + (b) * 2 + (h)) * HTB)
#define PG8_STAGE(bufoff, gbase, voff) do { _Pragma("unroll") for (int _i = 0; _i < 2; ++_i) \
        __builtin_amdgcn_global_load_lds((const unsigned*)((const char*)(gbase) + (voff)[_i]), (PG8_LAS unsigned*)(lds + (bufoff) + ldsw + _i * 8192), 16, 0, 0); } while (0)
#define PG8_LDA(dst, b, h) do { _Pragma("unroll") for (int m = 0; m < 4; ++m) _Pragma("unroll") for (int k = 0; k < 2; ++k) dst[m][k] = *(const PG8_LAS bf16x8*)(lds + PG8_SA(b, h) + aoff + m * 2048 + k * 1024); } while (0)
#define PG8_LDB(dst, b, h) do { _Pragma("unroll") for (int n = 0; n < 2; ++n) _Pragma("unroll") for (int k = 0; k < 2; ++k) dst[n][k] = *(const PG8_LAS bf16x8*)(lds + PG8_SB(b, h) + boff + n * 2048 + k * 1024); } while (0)
#define PG8_MMA(ai, bj, At, Bt) do { __builtin_amdgcn_s_setprio(1); _Pragma("unroll") for (int m = 0; m < 4; ++m) _Pragma("unroll") for (int n = 0; n < 2; ++n) _Pragma("unroll") for (int k = 0; k < 2; ++k) \
        acc[ai][bj][m][n] = __builtin_amdgcn_mfma_f32_16x16x32_bf16(Bt[n][k], At[m][k], acc[ai][bj][m][n], 0, 0, 0); __builtin_amdgcn_s_setprio(0); } while (0)
#define PG8_WAIT_V(n) asm volatile("s_waitcnt vmcnt(" #n ")" ::: "memory")
#define PG8_WAIT_L(n) asm volatile("s_waitcnt lgkmcnt(" #n ")" ::: "memory")
#define PG8_BAR __builtin_amdgcn_s_barrier()
#define PG8_SCHED __builtin_amdgcn_sched_barrier(0)
    Unit cur, nxt; int ui = 0;
    if (!S.next(0, cur)) return;
    f32x4 acc[2][2][4][2];
#pragma unroll
    for (int a = 0; a < 2; ++a)
#pragma unroll
        for (int b = 0; b < 2; ++b)
#pragma unroll
            for (int m = 0; m < 4; ++m)
#pragma unroll
                for (int n = 0; n < 2; ++n) acc[a][b][m][n] = (f32x4){0.f, 0.f, 0.f, 0.f};
    bf16x8 At[4][2], B0[2][2], B1[2][2];
    const char* cA = (const char*)g.A + (size_t)cur.pm * tstep; const char* cB = (const char*)g.Bt + (size_t)cur.pn * tstep;
    S.a_ready(cur);
    if constexpr (SP2) {
        PG8_STAGE(PG8_SB(0, 0), cB, voffB); PG8_STAGE(PG8_SB(0, 1), cB + hstep, voffB); PG8_STAGE(PG8_SA(0, 0), cA, voffA); PG8_STAGE(PG8_SA(0, 1), cA + hstep, voffA);
        if (wr == 1) PG8_BAR;
        PG8_WAIT_V(2); PG8_BAR;
        PG8_STAGE(PG8_SB(1, 0), cB + kstep, voffB); PG8_STAGE(PG8_SA(1, 0), cA + kstep, voffA); PG8_STAGE(PG8_SB(1, 1), cB + hstep + kstep, voffB);
        PG8_WAIT_V(6); PG8_BAR;
    } else {
        PG8_STAGE(PG8_SB(0, 0), cB, voffB); PG8_STAGE(PG8_SA(0, 0), cA, voffA); PG8_STAGE(PG8_SB(0, 1), cB + hstep, voffB); PG8_STAGE(PG8_SA(0, 1), cA + hstep, voffA);
        if (wr == 1) PG8_BAR;
        PG8_WAIT_V(4); PG8_BAR;
        PG8_STAGE(PG8_SB(1, 0), cB + kstep, voffB); PG8_STAGE(PG8_SA(1, 0), cA + kstep, voffA); PG8_STAGE(PG8_SB(1, 1), cB + hstep + kstep, voffB);
        PG8_WAIT_V(6); PG8_BAR;
    }
    for (;;) {
        const bool has_next = S.next(ui + 1, nxt);
        const char* nA = has_next ? (const char*)g.A + (size_t)nxt.pm * tstep : cA; const char* nB = has_next ? (const char*)g.Bt + (size_t)nxt.pn * tstep : cB;
        for (int t = 0; t < nt; t += 2) {
            const bool last = (t == nt - 2);
            const char* a1 = cA + (size_t)(t + 1) * kstep;
            const char* a2 = last ? nA : cA + (size_t)(t + 2) * kstep; const char* b2 = last ? nB : cB + (size_t)(t + 2) * kstep;
            const char* a3 = a2 + kstep; const char* b3 = b2 + kstep;
            if (last && has_next) S.a_ready(nxt);
            if constexpr (SP2) {
            PG8_LDB(B0, 0, 0); PG8_LDB(B1, 0, 1); PG8_SCHED; PG8_LDA(At, 0, 0); PG8_STAGE(PG8_SA(1, 1), a1 + hstep, voffA);
            PG8_WAIT_V(8); PG8_WAIT_L(0); PG8_BAR; PG8_MMA(0, 0, At, B0); PG8_MMA(0, 1, At, B1); PG8_BAR; PG8_SCHED;
            PG8_LDA(At, 0, 1); PG8_STAGE(PG8_SB(0, 0), b2, voffB); PG8_STAGE(PG8_SB(0, 1), b2 + hstep, voffB); PG8_STAGE(PG8_SA(0, 0), a2, voffA);
            PG8_WAIT_V(8); PG8_WAIT_L(0); PG8_BAR; PG8_MMA(1, 0, At, B0); PG8_MMA(1, 1, At, B1); PG8_BAR; PG8_SCHED;
            PG8_LDB(B0, 1, 0); PG8_LDB(B1, 1, 1); PG8_SCHED; PG8_LDA(At, 1, 0); PG8_STAGE(PG8_SA(0, 1), a2 + hstep, voffA);
            PG8_WAIT_V(8); PG8_WAIT_L(0); PG8_BAR; PG8_MMA(0, 0, At, B0); PG8_MMA(0, 1, At, B1); PG8_BAR; PG8_SCHED;
            PG8_LDA(At, 1, 1); PG8_STAGE(PG8_SB(1, 0), b3, voffB); PG8_STAGE(PG8_SB(1, 1), b3 + hstep, voffB); PG8_STAGE(PG8_SA(1, 0), a3, voffA);
            PG8_WAIT_V(8); PG8_WAIT_L(0); PG8_BAR; PG8_MMA(1, 0, At, B0); PG8_MMA(1, 1, At, B1); PG8_BAR; PG8_SCHED;
            } else {
            PG8_LDB(B0, 0, 0); PG8_SCHED; PG8_LDA(At, 0, 0); PG8_STAGE(PG8_SA(1, 1), a1 + hstep, voffA);
            PG8_WAIT_L(8); PG8_BAR; PG8_WAIT_L(0); PG8_MMA(0, 0, At, B0); PG8_BAR; PG8_SCHED;
            PG8_LDB(B1, 0, 1); PG8_STAGE(PG8_SB(0, 0), b2, voffB);
            PG8_BAR; PG8_WAIT_L(0); PG8_MMA(0, 1, At, B1); PG8_BAR;
            PG8_LDA(At, 0, 1); PG8_STAGE(PG8_SA(0, 0), a2, voffA);
            PG8_BAR; PG8_WAIT_L(0); PG8_MMA(1, 0, At, B0); PG8_BAR; PG8_SCHED;
            PG8_STAGE(PG8_SB(0, 1), b2 + hstep, voffB);
            PG8_WAIT_V(6); PG8_BAR; PG8_MMA(1, 1, At, B1); PG8_BAR;
            PG8_LDB(B0, 1, 0); PG8_SCHED; PG8_LDA(At, 1, 0); PG8_STAGE(PG8_SA(0, 1), a2 + hstep, voffA);
            PG8_WAIT_L(8); PG8_BAR; PG8_WAIT_L(0); PG8_MMA(0, 0, At, B0); PG8_BAR; PG8_SCHED;
            PG8_LDB(B1, 1, 1); PG8_STAGE(PG8_SB(1, 0), b3, voffB);
            PG8_BAR; PG8_WAIT_L(0); PG8_MMA(0, 1, At, B1); PG8_BAR;
            PG8_LDA(At, 1, 1); PG8_STAGE(PG8_SA(1, 0), a3, voffA);
            PG8_BAR; PG8_WAIT_L(0); PG8_MMA(1, 0, At, B0); PG8_BAR; PG8_SCHED;
            PG8_STAGE(PG8_SB(1, 1), b3 + hstep, voffB);
            PG8_WAIT_V(6); PG8_BAR; PG8_MMA(1, 1, At, B1); PG8_BAR;
            }
        }
        if constexpr (ALIGN_EPI) { if (wr == 0) PG8_BAR; }
        if constexpr (!Epi::AFTER_DRAIN) { E(acc, cur, wr, wc, fr, fq); S.done(cur); }
        if (!has_next) break;
#pragma unroll
        for (int a = 0; a < 2; ++a)
#pragma unroll
            for (int b = 0; b < 2; ++b)
#pragma unroll
                for (int m = 0; m < 4; ++m)
#pragma unroll
                    for (int n = 0; n < 2; ++n) acc[a][b][m][n] = (f32x4){0.f, 0.f, 0.f, 0.f};
        cur = nxt; cA = nA; cB = nB; ++ui;
        if constexpr (ALIGN_EPI) { if (wr == 1) PG8_BAR; }
    }
    PG8_WAIT_V(0);
    if constexpr (!ALIGN_EPI) { if (wr == 0) PG8_BAR; }
    PG8_BAR;
    if constexpr (Epi::AFTER_DRAIN) { E.fused(acc, cur, wr, wc, fr, fq, lds, wid, lane); S.done(cur); }
#undef PG8_SA
#undef PG8_SB
#undef PG8_STAGE
#undef PG8_LDA
#undef PG8_LDB
#undef PG8_MMA
#undef PG8_WAIT_V
#undef PG8_WAIT_L
#undef PG8_BAR
#undef PG8_SCHED
}
}

constexpr int NB = 2, SEQ = 4096, DM = 2048, MTOK = NB * SEQ, DI = 4096, PIN = 16384, PINP = PIN + 128  , DEPTH = 4, NMOD = 3 * DM;
constexpr float EPS = 1e-6f, LOG2E = 1.4426950408889634f, LN2 = 0.6931471805599453f;
constexpr size_t MiB = 1u << 20;
constexpr size_t WS_WIN = 0, WS_WOUT = 256 * MiB, WS_U = 320 * MiB, WS_PROJ = 352 * MiB, WS_G = 612 * MiB, WS_H = 676 * MiB,
                 WS_MOD = 740 * MiB, WS_LSE = 741 * MiB, WS_OG = 744 * MiB, WS_BAR = 840 * MiB, WS_END = 841 * MiB;
static_assert(WS_PROJ + (size_t)MTOK * PINP * 2 <= WS_G, "ws map");
constexpr int LDS_BYTES = 158720, LDS_BARST = 158656;
constexpr int CW_PANEL = 4096  , CW_WORDS = CW_PANEL + DEPTH * 32 * 64;
constexpr size_t WS_SLOTS = WS_BAR + 512 * 1024;

#define GAS __attribute__((address_space(1)))
#define LAS __attribute__((address_space(3)))
typedef unsigned short bf16;
typedef unsigned v4u __attribute__((ext_vector_type(4)));
typedef unsigned v2u __attribute__((ext_vector_type(2)));
typedef float f32x4 __attribute__((ext_vector_type(4)));
typedef float f32x16 __attribute__((ext_vector_type(16)));
typedef short bf16x8 __attribute__((ext_vector_type(8)));
typedef short s16x4 __attribute__((ext_vector_type(4)));
#define LDS_WAIT() asm volatile("s_waitcnt lgkmcnt(0)" ::: "memory")
__device__ __forceinline__ unsigned f2bf(float f) { unsigned u = __builtin_bit_cast(unsigned, f); return (u + 0x7fffu + ((u >> 16) & 1u)) >> 16; }
__device__ __forceinline__ unsigned pk2(float lo, float hi) { return f2bf(lo) | (f2bf(hi) << 16); }
__device__ __forceinline__ float bf2f(unsigned short h) { return __builtin_bit_cast(float, (unsigned)h << 16); }
__device__ __forceinline__ float bflo(unsigned w) { return __builtin_bit_cast(float, w << 16); }
__device__ __forceinline__ float bfhi(unsigned w) { return __builtin_bit_cast(float, w & 0xffff0000u); }
typedef float f32x2_t __attribute__((ext_vector_type(2))); typedef __bf16 bf16x2_t __attribute__((ext_vector_type(2)));
__device__ __forceinline__ unsigned cvtpk(float lo, float hi) { f32x2_t v = {lo, hi}; bf16x2_t b = __builtin_convertvector(v, bf16x2_t); return __builtin_bit_cast(unsigned, b); }
__device__ __forceinline__ float wave_sum(float v) {
#pragma unroll
    for (int o = 1; o < 64; o <<= 1) v += __shfl_xor(v, o);
    return v;
}
__device__ __forceinline__ float xpartner(float v, int hi) { auto rr = __builtin_amdgcn_permlane32_swap(__float_as_uint(v), __float_as_uint(v), false, false); return __uint_as_float(hi ? rr[0] : rr[1]); }
__device__ __forceinline__ float xmax(float v) { auto rr = __builtin_amdgcn_permlane32_swap(__float_as_uint(v), __float_as_uint(v), false, false); return fmaxf(__uint_as_float(rr[0]), __uint_as_float(rr[1])); }
__device__ __forceinline__ float xsum(float v) { auto rr = __builtin_amdgcn_permlane32_swap(__float_as_uint(v), __float_as_uint(v), false, false); return __uint_as_float(rr[0]) + __uint_as_float(rr[1]); }
__device__ __forceinline__ int crow(int r, int hi) { return (r & 3) + 8 * (r >> 2) + 4 * hi; }
__device__ __forceinline__ float silu(float v) { return v / (1.0f + __expf(-v)); }
__device__ __forceinline__ int t5_bucket(int rel) {
    if (rel < 16) return rel < 0 ? 0 : rel;
    int bk = 16;
    bk += rel >= 22; bk += rel >= 30; bk += rel >= 40; bk += rel >= 54; bk += rel >= 73; bk += rel >= 99; bk += rel >= 134; bk += rel >= 182;
    bk += rel >= 246; bk += rel >= 332; bk += rel >= 450; bk += rel >= 609; bk += rel >= 825; bk += rel >= 1117; bk += rel >= 1513;
    return bk;
}
__device__ __forceinline__ s16x4 vtr(const LAS char* p) { return __builtin_bit_cast(s16x4, __builtin_amdgcn_ds_read_tr16_b64_v4i16((LAS s16x4*)p)); }
#define MFMA32(a, b, c) __builtin_amdgcn_mfma_f32_32x32x16_bf16((a), (b), (c), 0, 0, 0)

__device__ __forceinline__ int opaque_tid() { int t = threadIdx.x; asm volatile("" : "+v"(t)); return t; }
struct Args { const float *x, *c, *norm_g, *w_mod, *b_mod, *w_in, *w_out, *rel_bias, *diff_lambda, *diff_subln_g, *final_norm_g; float* out; unsigned char* ws; };

__device__ __forceinline__ void p0_transpose_item(const float* W, int K, int N, bf16* WT, int row_off, LAS float* scr, int item, int lane) {
    const int nblk = N / 32, kb = item / nblk, nb = item % nblk, k0 = 64 * kb, n0 = 32 * nb;
#pragma unroll 8
    for (int i = 0; i < 32; ++i) { const int kk = 2 * i + (lane >> 5); scr[kk * 33 + (lane & 31)] = W[(size_t)(k0 + kk) * N + n0 + (lane & 31)]; }
    LDS_WAIT(); asm volatile("" ::: "memory");
    const int c = lane & 7;
#pragma unroll
    for (int j = 0; j < 4; ++j) { const int n = (lane >> 3) + 8 * j; const LAS float* s = scr + (8 * c) * 33 + n;
        v4u o; o.x = pk2(s[0 * 33], s[1 * 33]); o.y = pk2(s[2 * 33], s[3 * 33]); o.z = pk2(s[4 * 33], s[5 * 33]); o.w = pk2(s[6 * 33], s[7 * 33]);
        *(GAS v4u*)(WT + (size_t)(row_off + n0 + n) * K + k0 + 8 * c) = o; }
    LDS_WAIT(); asm volatile("" ::: "memory");
}
__device__ __forceinline__ void p0_prologue(const Args& a, LAS unsigned char* lds, int G) {
    const int tid = opaque_tid(), lane = tid & 63, wave = tid >> 6;
    LAS float* cs = (LAS float*)lds;
    LAS float* red = (LAS float*)(lds + 16384);
    float* MOD = (float*)(a.ws + WS_MOD);
    for (int i = tid; i < NB * DM; i += 512) cs[i] = silu(a.c[i]);
    __syncthreads();
    for (int item = blockIdx.x; item < DEPTH * (NMOD / 64); item += G) {
        const int l = item / (NMOD / 64), n0 = (item % (NMOD / 64)) * 64, kq = tid >> 4, cq = tid & 15;
        const float* W = a.w_mod + (size_t)l * DM * NMOD + n0 + 4 * cq;
        f32x4 a0 = {0.f, 0.f, 0.f, 0.f}, a1 = {0.f, 0.f, 0.f, 0.f};
#pragma unroll 8
        for (int k = kq; k < DM; k += 32) { const f32x4 w = *(const f32x4*)(W + (size_t)k * NMOD); a0 += w * cs[k]; a1 += w * cs[DM + k]; }
        *(LAS f32x4*)(red + (kq * 2 + 0) * 64 + 4 * cq) = a0; *(LAS f32x4*)(red + (kq * 2 + 1) * 64 + 4 * cq) = a1;
        __syncthreads();
        if (tid < 128) { const int b = tid >> 6, col = tid & 63; float s = 0.f;
#pragma unroll 8
            for (int q = 0; q < 32; ++q) s += red[(q * 2 + b) * 64 + col];
            MOD[((size_t)l * NB + b) * NMOD + n0 + col] = s + a.b_mod[(size_t)l * NMOD + n0 + col]; }
        __syncthreads();
    }
    __syncthreads();
    LAS float* scr = (LAS float*)(lds + wave * 16384);
    const int gw = blockIdx.x * 8 + wave, NGW = G * 8;
    constexpr int I_IN = (DM / 64) * (PIN / 32), I_OUT = (DI / 64) * (DM / 32);
    for (int it = gw; it < DEPTH * (I_IN + I_OUT); it += NGW) {
        const int l = it / (I_IN + I_OUT); int r = it % (I_IN + I_OUT);
        if (r < I_IN) p0_transpose_item(a.w_in + (size_t)l * DM * PIN, DM, PIN, (bf16*)(a.ws + WS_WIN) + (size_t)l * PIN * DM, 0, scr, r, lane);
        else p0_transpose_item(a.w_out + (size_t)l * DI * DM, DI, DM, (bf16*)(a.ws + WS_WOUT) + (size_t)l * DM * DI, 0, scr, r - I_IN, lane);
    }
}

template <bool FINAL> __device__ __forceinline__ void rows_phase(const float* hin, const float* g, const float* mod, bf16* uout, float* fout, int G) {
    const int tid = opaque_tid(), lane = tid & 63, gw = blockIdx.x * 8 + (tid >> 6), NGW = G * 8;
    for (int m = gw; m < MTOK; m += NGW) {
        const f32x4* xr = (const f32x4*)(hin + (size_t)m * DM) + lane;
        f32x4 v[8]; float s = 0.f;
#pragma unroll
        for (int j = 0; j < 8; ++j) { v[j] = xr[64 * j]; s += (v[j].x * v[j].x + v[j].y * v[j].y) + (v[j].z * v[j].z + v[j].w * v[j].w); }
        const float rstd = 1.0f / sqrtf(wave_sum(s) * (1.0f / DM) + EPS);
        const int b = m / SEQ;
#pragma unroll
        for (int j = 0; j < 8; ++j) {
            const int col = 4 * lane + 256 * j;
            const f32x4 gv = *(const f32x4*)(g + col);
            f32x4 y = v[j] * rstd * gv;
            if (FINAL) { *((f32x4*)(fout + (size_t)m * DM + col)) = y; }
            else {
                const f32x4 sh = *(const f32x4*)(mod + (size_t)b * NMOD + col), sc = *(const f32x4*)(mod + (size_t)b * NMOD + DM + col);
                y = y * (sc + 1.0f) + sh;
                v2u o; o.x = pk2(y.x, y.y); o.y = pk2(y.z, y.w);
                *(v2u*)(uout + (size_t)m * DM + col) = o;
            }
        }
    }
}

constexpr int VSTR = 320;
constexpr int KSTR = 272;
constexpr int K64STR = 144;
__device__ __forceinline__ void pv32(f32x16 (&o)[4], const LAS char* vt, bf16x8 pb0, bf16x8 pb1) {
#pragma unroll
    for (int c = 0; c < 4; ++c) {
        const s16x4 l0 = vtr(vt + c * 64), h0 = vtr(vt + 8 * VSTR + c * 64), l1 = vtr(vt + 16 * VSTR + c * 64), h1 = vtr(vt + 24 * VSTR + c * 64);
        const bf16x8 a0 = {l0[0], l0[1], l0[2], l0[3], h0[0], h0[1], h0[2], h0[3]}, a1 = {l1[0], l1[1], l1[2], l1[3], h1[0], h1[1], h1[2], h1[3]};
        o[c] = MFMA32(a0, pb0, o[c]); o[c] = MFMA32(a1, pb1, o[c]);
    }
}
__device__ __forceinline__ void pv32x2(f32x16 (&o1)[4], f32x16 (&o2)[4], const LAS char* vt, bf16x8 p1b0, bf16x8 p1b1, bf16x8 p2b0, bf16x8 p2b1) {
#pragma unroll
    for (int c = 0; c < 4; ++c) {
        const s16x4 l0 = vtr(vt + c * 64), h0 = vtr(vt + 8 * VSTR + c * 64), l1 = vtr(vt + 16 * VSTR + c * 64), h1 = vtr(vt + 24 * VSTR + c * 64);
        const bf16x8 a0 = {l0[0], l0[1], l0[2], l0[3], h0[0], h0[1], h0[2], h0[3]}, a1 = {l1[0], l1[1], l1[2], l1[3], h1[0], h1[1], h1[2], h1[3]};
        o1[c] = MFMA32(a0, p1b0, o1[c]); o1[c] = MFMA32(a1, p1b1, o1[c]);
        o2[c] = MFMA32(a0, p2b0, o2[c]); o2[c] = MFMA32(a1, p2b1, o2[c]);
    }
}

__device__ __forceinline__ void pv32s(f32x16 (&o)[4], const LAS char* vt, int xq, bf16x8 pb0, bf16x8 pb1) {
    __builtin_amdgcn_s_setprio(1);
#pragma unroll
    for (int c = 0; c < 4; ++c) {
        const LAS char* vc = vt + ((64 * c) ^ xq);
        const s16x4 l0 = vtr(vc), h0 = vtr(vc + 8 * 256), l1 = vtr(vc + 16 * 256), h1 = vtr(vc + 24 * 256);
        const bf16x8 a0 = {l0[0], l0[1], l0[2], l0[3], h0[0], h0[1], h0[2], h0[3]}, a1 = {l1[0], l1[1], l1[2], l1[3], h1[0], h1[1], h1[2], h1[3]};
        o[c] = MFMA32(a0, pb0, o[c]); o[c] = MFMA32(a1, pb1, o[c]);
    }
    __builtin_amdgcn_s_setprio(0);
}
__device__ __forceinline__ void pv32x2s(f32x16 (&o1)[4], f32x16 (&o2)[4], const LAS char* vt, int xq, bf16x8 p1b0, bf16x8 p1b1, bf16x8 p2b0, bf16x8 p2b1) {
#pragma unroll
    for (int c = 0; c < 4; ++c) {
        const LAS char* vc = vt + ((64 * c) ^ xq);
        const s16x4 l0 = vtr(vc), h0 = vtr(vc + 8 * 256), l1 = vtr(vc + 16 * 256), h1 = vtr(vc + 24 * 256);
        const bf16x8 a0 = {l0[0], l0[1], l0[2], l0[3], h0[0], h0[1], h0[2], h0[3]}, a1 = {l1[0], l1[1], l1[2], l1[3], h1[0], h1[1], h1[2], h1[3]};
        o1[c] = MFMA32(a0, p1b0, o1[c]); o1[c] = MFMA32(a1, p1b1, o1[c]);
        o2[c] = MFMA32(a0, p2b0, o2[c]); o2[c] = MFMA32(a1, p2b1, o2[c]);
    }
}
__device__ __forceinline__ void glds16(const void* gsrc, unsigned lds_dst) { unsigned keep;
    asm volatile("s_mov_b32 %0, m0\n\ts_mov_b32 m0, %2\n\ts_nop 0\n\tglobal_load_lds_dwordx4 %1, off\n\ts_mov_b32 m0, %0" : "=&s"(keep) : "v"(gsrc), "s"(lds_dst) : "memory"); }
#define GLDS16(gsrc, ldsdst) glds16((const void*)(gsrc), (unsigned)__builtin_amdgcn_readfirstlane((int)(unsigned)(size_t)(ldsdst)))
template <int THR> __device__ __forceinline__ void softmax_block(f32x16& s, float& m, float& l, f32x16 (&o)[4], bf16x8& pb0, bf16x8& pb1) {
    float mx = fmaxf(fmaxf(s[0], s[1]), s[2]);
#pragma unroll
    for (int r = 3; r < 15; r += 2) mx = fmaxf(fmaxf(mx, s[r]), s[r + 1]);
    mx = fmaxf(mx, s[15]);
    mx = xmax(mx);
    if (__any(mx > m + (float)THR)) {
        const float mn = fmaxf(m, mx);
        const float al = __builtin_amdgcn_exp2f(m - mn); l *= al;
#pragma unroll
        for (int c = 0; c < 4; ++c)
#pragma unroll
            for (int r = 0; r < 16; ++r) o[c][r] *= al;
        m = mn;
    }
    float sum = 0.f;
#pragma unroll
    for (int r = 0; r < 16; ++r) { s[r] = __builtin_amdgcn_exp2f(s[r] - m); sum += s[r]; }
    l += sum;
    v4u w0, w1;
    w0.x = cvtpk(s[0], s[1]); w0.y = cvtpk(s[2], s[3]); w0.z = cvtpk(s[4], s[5]); w0.w = cvtpk(s[6], s[7]);
    w1.x = cvtpk(s[8], s[9]); w1.y = cvtpk(s[10], s[11]); w1.z = cvtpk(s[12], s[13]); w1.w = cvtpk(s[14], s[15]);
    pb0 = __builtin_bit_cast(bf16x8, w0); pb1 = __builtin_bit_cast(bf16x8, w1);
}


__device__ __forceinline__ void k_load(const bf16* proj, int tk0, int d, int kcol, int r32, int hi, bf16x8 (&kf)[8]) {
    const int tk = max(tk0 + d * r32, 0); const bf16* kp = proj + (size_t)tk * PINP + kcol + hi * 8;
#pragma unroll
    for (int ss = 0; ss < 8; ++ss) kf[ss] = *(const bf16x8*)(kp + 16 * ss);
}
__device__ __forceinline__ void v_dma(const bf16* proj, int tk0, int d, int vcol, int lane, LAS unsigned char* vbuf) {
    const int c = (lane & 15) ^ (((lane >> 4) & 3) << 2);
#pragma unroll
    for (int i = 0; i < 8; ++i) { const int tk = max(tk0 + d * (4 * i + (lane >> 4)), 0);
        GLDS16(proj + (size_t)tk * PINP + vcol + c * 8, vbuf + i * 1024); }
}

constexpr int DF_TBLN = 1664;
constexpr int DF_TBL = 0, DF_BUF = 6656, DF_BUFB = 32768  , DF_Q = DF_BUF + 2 * DF_BUFB, DF_QW = 32 * KSTR  ;
static_assert(DF_Q + 8 * DF_QW <= LDS_BARST, "diff attention LDS map");
__device__ __forceinline__ void diff_unit(const Args& a, LAS unsigned char* lds, int layer, int bh, int qb) {
    const int tid = opaque_tid(), lane = tid & 63, r32 = lane & 31, hi = lane >> 5, wave = __builtin_amdgcn_readfirstlane(tid >> 6);
    const int b = bh >> 4, h = bh & 15, e = layer >> 1;
    const bf16* proj = (const bf16*)(a.ws + WS_PROJ) + (size_t)b * SEQ * PINP;
    bf16* Gout = (bf16*)(a.ws + WS_G) + (size_t)b * SEQ * DI;
    LAS float* tbl = (LAS float*)(lds + DF_TBL);
    __syncthreads();
    for (int i = tid; i < DF_TBLN; i += 512) { const int rel = i - 64; tbl[i] = rel < 0 ? -INFINITY : a.rel_bias[t5_bucket(rel) * 32 + 16 + h] * LOG2E; }
    const int q0w = qb * 256 + wave * 32;
    LAS unsigned char* qw = lds + DF_Q + wave * DF_QW;
#pragma unroll
    for (int i = 0; i < 8; ++i) { const int idx = lane + 64 * i, row = idx >> 4, ch = idx & 15;
        v4u v = *(const v4u*)(proj + (size_t)(q0w + row) * PINP + (ch < 8 ? 6144 + h * 64 + ch * 8 : 7168 + h * 64 + (ch - 8) * 8));
#pragma unroll
        for (int k = 0; k < 4; ++k) v[k] = cvtpk(bflo(v[k]) * (0.125f * LOG2E), bfhi(v[k]) * (0.125f * LOG2E));
        *(LAS v4u*)(qw + row * KSTR + ch * 16) = v; }
    const int NT = 4 * qb + 4;
    const int kr_ = 8 * wave + (lane >> 3), kc_ = (lane & 7) ^ ((4 * wave + (lane >> 4)) & 7);
    const bf16* k1src = proj + (size_t)kr_ * PINP + 8192 + h * 64 + kc_ * 8;
    const bf16* k2src = proj + (size_t)kr_ * PINP + 9216 + h * 64 + kc_ * 8;
    const int vr_ = 8 * wave + (lane >> 4), vc_ = (lane & 15) ^ (((lane >> 4) & 3) << 2);
    const bf16* vsrc = proj + (size_t)vr_ * PINP + 10240 + h * 128 + vc_ * 8;
#define DF_DMA(t, bufp) do { const size_t o_ = (size_t)(t) * 64 * PINP; LAS unsigned char* b_ = (bufp) + wave * 1024; \
        GLDS16(k1src + o_, b_); GLDS16(k2src + o_, b_ + 8192); GLDS16(vsrc + o_, b_ + 16384 + wave * 1024); GLDS16(vsrc + o_ + (size_t)4 * PINP, b_ + 16384 + wave * 1024 + 1024); } while (0)
    DF_DMA(0, lds + DF_BUF);
    f32x16 o1[4], o2[4];
#pragma unroll
    for (int c = 0; c < 4; ++c) { o1[c] = f32x16{}; o2[c] = f32x16{}; }
    float m1 = -1e30f, l1 = 0.f, m2 = -1e30f, l2 = 0.f;
    const int qpos = q0w + r32;
    const LAS unsigned char* qrd = qw + r32 * KSTR + hi * 16;
    const int kfo = r32 * 128 + (((hi ^ (r32 >> 1)) & 1) * 16), kxt = ((r32 >> 1) & 6) * 16;
    const int vto = (4 * hi + ((lane & 15) >> 2)) * 256 + ((lane >> 4) & 1) * 32 + (lane & 3) * 8, vxq = 64 * ((lane & 15) >> 2);
    asm volatile("s_waitcnt vmcnt(0)" ::: "memory");
    __syncthreads();
    for (int t = 0; t < NT; ++t) {
        LAS unsigned char* buf = lds + DF_BUF + (t & 1) * DF_BUFB;
        if (t + 1 < NT) DF_DMA(t + 1, lds + DF_BUF + ((t + 1) & 1) * DF_BUFB);
#pragma unroll
        for (int half = 0; half < 2; ++half) {
            const int kb = t * 64 + half * 32;
            if (kb > q0w + 31) continue;
            const LAS unsigned char* k1p = buf + half * 32 * 128 + kfo;
            const LAS unsigned char* k2p = k1p + 8192;
            const int rel0 = qpos - kb - 4 * hi;
            const LAS float* tb = tbl + 64 + min(rel0, 1562);
            f32x16 s1, s2;
#pragma unroll
            for (int r = 0; r < 16; ++r) { s1[r] = tb[-((r & 3) + 8 * (r >> 2))]; s2[r] = s1[r]; }
            __builtin_amdgcn_s_setprio(1);
#pragma unroll
            for (int s = 0; s < 4; ++s) s1 = MFMA32(*(const LAS bf16x8*)(k1p + ((32 * s) ^ kxt)), *(const LAS bf16x8*)(qrd + 32 * s), s1);
#pragma unroll
            for (int s = 0; s < 4; ++s) s2 = MFMA32(*(const LAS bf16x8*)(k2p + ((32 * s) ^ kxt)), *(const LAS bf16x8*)(qrd + 128 + 32 * s), s2);
            __builtin_amdgcn_s_setprio(0);
            const LAS char* vt_ = (const LAS char*)(buf + 16384 + half * 32 * 256 + vto);
            { bf16x8 pb0, pb1; softmax_block<8>(s1, m1, l1, o1, pb0, pb1); pv32s(o1, vt_, vxq, pb0, pb1); }
            { bf16x8 pb0, pb1; softmax_block<8>(s2, m2, l2, o2, pb0, pb1); pv32s(o2, vt_, vxq, pb0, pb1); }
        }
        asm volatile("s_waitcnt vmcnt(0)" ::: "memory");
        __syncthreads();
    }
#undef DF_DMA
    float lam;
    { const float* lv = a.diff_lambda + (size_t)e * 256; const float p1 = wave_sum(lv[lane] * lv[64 + lane]), p2 = wave_sum(lv[128 + lane] * lv[192 + lane]);
      lam = __expf(p1) - __expf(p2) + (layer == 0 ? 0.2f : 0.47071302f); }
    const float i1 = 1.0f / xsum(l1), i2 = lam / xsum(l2);
    float ssq = 0.f;
#pragma unroll
    for (int c = 0; c < 4; ++c)
#pragma unroll
        for (int r = 0; r < 16; ++r) { const float v = o1[c][r] * i1 - o2[c][r] * i2; o1[c][r] = v; ssq += v * v; }
    ssq = xsum(ssq);
    const float lam_init = layer == 0 ? 0.2f : 0.47071302f;
    const float rn = (1.0f / sqrtf(ssq * (1.0f / 128.0f) + EPS)) * (1.0f - lam_init);
    const float* sg = a.diff_subln_g + (size_t)e * 128;
    const bf16* zrow = proj + (size_t)qpos * PINP + 12288 + 2048 + h * 128;
    bf16* orow = Gout + (size_t)qpos * DI + 2048 + h * 128;
#pragma unroll
    for (int c = 0; c < 4; ++c)
#pragma unroll
        for (int g4 = 0; g4 < 4; ++g4) {
            const int d0 = 32 * c + 8 * g4 + 4 * hi;
            const v2u zz = *(const v2u*)(zrow + d0); const f32x4 gg = *(const f32x4*)(sg + d0);
            const float y0 = o1[c][4 * g4 + 0] * rn * gg.x * bflo(zz.x), y1 = o1[c][4 * g4 + 1] * rn * gg.y * bfhi(zz.x),
                        y2 = o1[c][4 * g4 + 2] * rn * gg.z * bflo(zz.y), y3 = o1[c][4 * g4 + 3] * rn * gg.w * bfhi(zz.y);
            v2u w; w.x = cvtpk(y0, y1); w.y = cvtpk(y2, y3);
            *(v2u*)(orow + d0) = w;
        }
}

constexpr int DL_TBL = 0  , DL_V = 2048, DL_VW = 16384  ;
static_assert(DL_V + 8 * DL_VW <= LDS_BARST, "dilated attention LDS map");
__device__ __forceinline__ void dilated_unit(const Args& a, LAS unsigned char* lds, int bh, int blk) {
    const int tid = opaque_tid(), lane = tid & 63, r32 = lane & 31, hi = lane >> 5, wave = __builtin_amdgcn_readfirstlane(tid >> 6);
    const int b = bh >> 4, h = bh & 15, Q0 = blk * 512;
    const bf16* proj = (const bf16*)(a.ws + WS_PROJ) + (size_t)b * SEQ * PINP;
    bf16* OG = (bf16*)(a.ws + WS_OG); float* LSE = (float*)(a.ws + WS_LSE);
    LAS float* tbl = (LAS float*)(lds + DL_TBL);
    __syncthreads();
    for (int i = tid; i < 3 * 132; i += 512) { const int g = i / 132, j = i % 132; tbl[i] = a.rel_bias[t5_bucket(j << (2 * g)) * 32 + h] * LOG2E; }
    __syncthreads();
    LAS unsigned char* vw = lds + DL_V + wave * DL_VW;
    const int vto = (4 * hi + ((lane & 15) >> 2)) * 256 + ((lane >> 4) & 1) * 32 + (lane & 3) * 8, vxq = 64 * ((lane & 15) >> 2);
    const float scl = 0.08838834764831845f * LOG2E;
#pragma unroll 1
    for (int tau = wave; tau < 48; tau += 8) {
        const int g = tau >> 4, sub = tau & 15, dsh = 2 * g, d = 1 << dsh, per = 16 >> dsh;
        const int res = sub / per, ti = sub % per;
        const int tq0 = Q0 + res + d * 32 * ti;
        const int tq = tq0 + d * r32;
        bf16x8 qf[8];
        { const bf16* qp = proj + (size_t)tq * PINP + h * 128 + hi * 8;
#pragma unroll
          for (int s = 0; s < 8; ++s) qf[s] = *(const bf16x8*)(qp + 16 * s); }
        f32x16 o[4];
#pragma unroll
        for (int c = 0; c < 4; ++c) o[c] = f32x16{};
        float m = -1e30f, l = 0.f;
        int kb = 0;
        while (tq0 - 128 * d + d * 32 * kb + 31 * d < 0) ++kb;
        bf16x8 kf[8];
        asm volatile("s_waitcnt lgkmcnt(0)" ::: "memory");
        v_dma(proj, tq0 - 128 * d + d * 32 * kb, d, 4096 + h * 128, lane, vw + (kb & 1) * 8192);
        k_load(proj, tq0 - 128 * d + d * 32 * kb, d, 2048 + h * 128, r32, hi, kf);
#pragma unroll 1
        for (; kb < 5; ++kb) {
            const int tk0 = tq0 - 128 * d + d * 32 * kb;
            asm volatile("s_waitcnt vmcnt(0)" ::: "memory");
            f32x16 s = f32x16{};
#pragma unroll
            for (int ss = 0; ss < 8; ++ss) s = MFMA32(kf[ss], qf[ss], s);
            if (kb < 4) { v_dma(proj, tk0 + d * 32, d, 4096 + h * 128, lane, vw + ((kb + 1) & 1) * 8192);
                          k_load(proj, tk0 + d * 32, d, 2048 + h * 128, r32, hi, kf); }
            const int j0 = r32 + 128 - 32 * kb - 4 * hi;
#pragma unroll
            for (int r = 0; r < 16; ++r) {
                const int kk = (r & 3) + 8 * (r >> 2); const int j = j0 - kk;
                const bool valid = (j >= 0) && (j <= 128) && (tk0 + d * (kk + 4 * hi) >= 0);
                const float bv = tbl[g * 132 + min(max(j, 0), 128)];
                s[r] = valid ? s[r] * scl + bv : -INFINITY;
            }
            bf16x8 pb0, pb1;
            softmax_block<8>(s, m, l, o, pb0, pb1);
            pv32s(o, (const LAS char*)(vw + (kb & 1) * 8192 + vto), vxq, pb0, pb1);
        }
        const float lt = xsum(l); const float il = 1.0f / lt;
        bf16* orow = OG + ((size_t)g * MTOK + (size_t)b * SEQ + tq) * DM + h * 128;
#pragma unroll
        for (int c = 0; c < 4; ++c)
#pragma unroll
            for (int g4 = 0; g4 < 4; ++g4) {
                v2u w; w.x = cvtpk(o[c][4 * g4] * il, o[c][4 * g4 + 1] * il); w.y = cvtpk(o[c][4 * g4 + 2] * il, o[c][4 * g4 + 3] * il);
                *(v2u*)(orow + 32 * c + 8 * g4 + 4 * hi) = w;
            }
        if (hi == 0) LSE[((size_t)g * MTOK + (size_t)b * SEQ + tq) * 16 + h] = (m + __builtin_amdgcn_logf(lt)) * LN2;
    }
    asm volatile("s_waitcnt vmcnt(0)" ::: "memory");
    __threadfence_block();
    __syncthreads();
    bf16* Gout = (bf16*)(a.ws + WS_G) + (size_t)b * SEQ * DI;
    for (int p0 = 0; p0 < 16; p0 += 4) {
        const int ch = tid & 15;
        float e0[4], e1[4], e2[4]; v4u a0[4], a1[4], a2[4], zz[4];
#pragma unroll
        for (int u = 0; u < 4; ++u) {
            const int tq = Q0 + (p0 + u) * 32 + (tid >> 4); const size_t tok = (size_t)b * SEQ + tq;
            e0[u] = LSE[((size_t)0 * MTOK + tok) * 16 + h]; e1[u] = LSE[((size_t)1 * MTOK + tok) * 16 + h]; e2[u] = LSE[((size_t)2 * MTOK + tok) * 16 + h];
            a0[u] = *(const v4u*)(OG + ((size_t)0 * MTOK + tok) * DM + h * 128 + ch * 8); a1[u] = *(const v4u*)(OG + ((size_t)1 * MTOK + tok) * DM + h * 128 + ch * 8);
            a2[u] = *(const v4u*)(OG + ((size_t)2 * MTOK + tok) * DM + h * 128 + ch * 8);
            zz[u] = *(const v4u*)(proj + (size_t)tq * PINP + 12288 + h * 128 + ch * 8);
        }
#pragma unroll
        for (int u = 0; u < 4; ++u) {
            const int tq = Q0 + (p0 + u) * 32 + (tid >> 4);
            const float mx = fmaxf(e0[u], fmaxf(e1[u], e2[u])); float w0 = __expf(e0[u] - mx), w1 = __expf(e1[u] - mx), w2 = __expf(e2[u] - mx);
            const float inv = 1.0f / (w0 + w1 + w2); w0 *= inv; w1 *= inv; w2 *= inv;
            v4u w;
#pragma unroll
            for (int k = 0; k < 4; ++k) {
                const float lo = (w0 * bflo(a0[u][k]) + w1 * bflo(a1[u][k]) + w2 * bflo(a2[u][k])) * bflo(zz[u][k]);
                const float hh = (w0 * bfhi(a0[u][k]) + w1 * bfhi(a1[u][k]) + w2 * bfhi(a2[u][k])) * bfhi(zz[u][k]);
                w[k] = cvtpk(lo, hh);
            }
            *(v4u*)(Gout + (size_t)tq * DI + h * 128 + ch * 8) = w;
        }
    }
}

constexpr int SK_SLOT = 16384, SK_NSLOT = 9, SK_FLAG = SK_NSLOT * SK_SLOT;
static_assert(SK_FLAG + 64 <= LDS_BARST, "stick-breaking LDS map");
__device__ __forceinline__ void stick_unit(const Args& a, LAS unsigned char* lds, int bh, int qb) {
    const int tid = opaque_tid(), lane = tid & 63, r32 = lane & 31, hi = lane >> 5, wave = __builtin_amdgcn_readfirstlane(tid >> 6);
    const int b = bh >> 5, h = bh & 31;
    const bf16* proj = (const bf16*)(a.ws + WS_PROJ) + (size_t)b * SEQ * PINP;
    bf16* Gout = (bf16*)(a.ws + WS_G) + (size_t)b * SEQ * DI;
    LAS unsigned* flags = (LAS unsigned*)(lds + SK_FLAG);
    const int Q0 = qb * 256, q0w = Q0 + wave * 32, qpos = q0w + r32;
    bf16x8 qf[8];
    { const bf16* qp = proj + (size_t)qpos * PINP + h * 128 + hi * 8;
#pragma unroll
      for (int s = 0; s < 8; ++s) qf[s] = *(const bf16x8*)(qp + 16 * s); }
    v2u zz[16];
    { const bf16* zrow = proj + (size_t)qpos * PINP + 12288 + h * 128 + 4 * hi;
#pragma unroll
      for (int i = 0; i < 16; ++i) zz[i] = *(const v2u*)(zrow + 32 * (i >> 2) + 8 * (i & 3)); }
    const int drow = 4 * wave + (lane >> 4);
    const bf16* ksrc = proj + (size_t)drow * PINP + 4096 + h * 128 + (((lane & 15) ^ (drow & 15)) * 8);
    const bf16* vsrc = proj + (size_t)drow * PINP + 8192 + h * 128 + (((lane & 15) ^ (((lane >> 4) & 3) << 2)) * 8);
#define SK_DMA(y) do { const int kb_ = Q0 + 224 - 32 * (y); if (kb_ >= 0) { LAS unsigned char* sl_ = lds + ((y) % SK_NSLOT) * SK_SLOT + wave * 1024; \
        GLDS16(ksrc + (size_t)kb_ * PINP, sl_); GLDS16(vsrc + (size_t)kb_ * PINP, sl_ + 8192); } } while (0)
    __syncthreads();
#pragma unroll 1
    for (int y = 0; y < 8; ++y) SK_DMA(y);
    f32x16 o[4];
#pragma unroll
    for (int c = 0; c < 4; ++c) o[c] = f32x16{};
    float R = 0.f;
    const float scl = 0.08838834764831845f;
    const int kfo = r32 * 256 + (((hi ^ r32) & 1) * 16), kxt = (r32 & 14) * 16;
    const int vto = (4 * hi + ((lane & 15) >> 2)) * 256 + ((lane >> 4) & 1) * 32 + (lane & 3) * 8, vxq = 64 * ((lane & 15) >> 2);
#pragma unroll
    for (int i = 0; i < 16; ++i) asm volatile("" : "+v"(zz[i]));
#pragma unroll 1
    for (int j = 0;; ++j) {
        asm volatile("s_waitcnt vmcnt(0)" ::: "memory");
        __syncthreads();
        if (j > 0) { unsigned alld = 1u;
#pragma unroll
            for (int w = 0; w < 8; ++w) alld &= flags[((j - 1) & 1) * 8 + w];
            if (alld) break; }
        SK_DMA(8 + j);
        const int kb = q0w - 32 * j;
        if (kb >= 0 && !__all(R < -40.0f)) {
            const LAS unsigned char* slot = lds + ((7 - wave + j) % SK_NSLOT) * SK_SLOT;
            f32x16 s = f32x16{};
#pragma unroll
            for (int ss = 0; ss < 8; ++ss) s = MFMA32(*(const LAS bf16x8*)(slot + kfo + ((32 * ss) ^ kxt)), qf[ss], s);
            const bool diag = j == 0;
            const int rel0 = qpos - kb - 4 * hi;
            f32x16 lb;
#pragma unroll
            for (int r = 0; r < 16; ++r) {
                const float z = s[r] * scl;
                const float sp = fmaxf(z, 0.f) + __builtin_amdgcn_logf(1.0f + __builtin_amdgcn_exp2f(-fabsf(z) * LOG2E)) * LN2;
                const bool valid = !diag || (rel0 - ((r & 3) + 8 * (r >> 2)) > 0);
                s[r] = valid ? -sp : 0.f;
                lb[r] = valid ? z - sp : -INFINITY;
            }
            float gs[4], ps[4], E[4];
#pragma unroll
            for (int g = 0; g < 4; ++g) { gs[g] = (s[4 * g] + s[4 * g + 1]) + (s[4 * g + 2] + s[4 * g + 3]); ps[g] = xpartner(gs[g], hi); }
            float run = 0.f;
#pragma unroll
            for (int g = 3; g >= 0; --g) { E[g] = run + (hi == 0 ? ps[g] : 0.f); run += gs[g] + ps[g]; }
#pragma unroll
            for (int g = 0; g < 4; ++g) {
                const float base = R + E[g];
                const float t3 = base, t2 = t3 + s[4 * g + 3], t1 = t2 + s[4 * g + 2], t0 = t1 + s[4 * g + 1];
                s[4 * g + 3] = __builtin_amdgcn_exp2f((lb[4 * g + 3] + t3) * LOG2E); s[4 * g + 2] = __builtin_amdgcn_exp2f((lb[4 * g + 2] + t2) * LOG2E);
                s[4 * g + 1] = __builtin_amdgcn_exp2f((lb[4 * g + 1] + t1) * LOG2E); s[4 * g + 0] = __builtin_amdgcn_exp2f((lb[4 * g + 0] + t0) * LOG2E);
            }
            R += run;
            v4u w0, w1;
            w0.x = cvtpk(s[0], s[1]); w0.y = cvtpk(s[2], s[3]); w0.z = cvtpk(s[4], s[5]); w0.w = cvtpk(s[6], s[7]);
            w1.x = cvtpk(s[8], s[9]); w1.y = cvtpk(s[10], s[11]); w1.z = cvtpk(s[12], s[13]); w1.w = cvtpk(s[14], s[15]);
            pv32s(o, (const LAS char*)(slot + 8192 + vto), vxq, __builtin_bit_cast(bf16x8, w0), __builtin_bit_cast(bf16x8, w1));
        }
        if (lane == 0) flags[(j & 1) * 8 + wave] = (kb - 32 < 0 || __all(R < -40.0f)) ? 1u : 0u;
    }
#undef SK_DMA
    bf16* orow = Gout + (size_t)qpos * DI + h * 128;
#pragma unroll
    for (int c = 0; c < 4; ++c)
#pragma unroll
        for (int g4 = 0; g4 < 4; ++g4) {
            const int d0 = 32 * c + 8 * g4 + 4 * hi;
            const v2u z2 = zz[c * 4 + g4];
            v2u w; w.x = cvtpk(o[c][4 * g4 + 0] * bflo(z2.x), o[c][4 * g4 + 1] * bfhi(z2.x)); w.y = cvtpk(o[c][4 * g4 + 2] * bflo(z2.y), o[c][4 * g4 + 3] * bfhi(z2.y));
            *(v2u*)(orow + d0) = w;
        }
}

#define XB_TMO      128
#define XB_XCNT(j)  (256  + 64 * (j))
#define XB_XSUB(j)  (1280 + 64 * (j))
#define XB_XGEN(j)  (2304 + 64 * (j))
#define XB_TOP      3328
#define XB_TOPGEN   3392
#define XCD_BAR_WORDS 3456
#define XB_SPIN_CAP (1u << 18)

__device__ __forceinline__ unsigned xb_ld(unsigned* p)              { return __hip_atomic_load(p, __ATOMIC_RELAXED, __HIP_MEMORY_SCOPE_AGENT); }
__device__ __forceinline__ unsigned xb_add(unsigned* p, unsigned v) { return __hip_atomic_fetch_add(p, v, __ATOMIC_RELAXED, __HIP_MEMORY_SCOPE_AGENT); }
__device__ __forceinline__ unsigned xb_xcc_id() { return (unsigned)__builtin_amdgcn_s_getreg((3 << 11) | 20) & 0xFu; }
#define XB_SPIN(cond, bar) do { unsigned _sp = 0; while (cond) { __builtin_amdgcn_s_sleep(1); \
    if ((++_sp & 255u) == 0u) { if (xb_ld(&(bar)[XB_TMO])) break; if (_sp > XB_SPIN_CAP) { atomicAdd(&(bar)[XB_TMO], 1u); break; } } } } while (0)

struct XcdBarrier {
    unsigned* bar; unsigned x;
    volatile LAS unsigned* st;
};

__device__ __forceinline__ XcdBarrier xcd_barrier_post(unsigned* bar, volatile LAS unsigned* st) {
    XcdBarrier b; b.bar = bar; b.x = xb_xcc_id(); b.st = st;
    if (threadIdx.x == 0) (void)xb_add(&bar[XB_XCNT(b.x)], 1u);
    return b;
}
__device__ __forceinline__ void xcd_barrier_complete(unsigned* bar, unsigned x, unsigned& nloc, unsigned& nx) {
    const unsigned G = gridDim.x * gridDim.y * gridDim.z;
    unsigned sum, cnt, mine, sp = 0u;
    for (;;) {
        sum = 0u; cnt = 0u; mine = 0u;
        unsigned cv[16];
#pragma unroll
        for (unsigned j = 0; j < 16; ++j) asm volatile("global_load_dword %0, %1, off sc1" : "=v"(cv[j]) : "v"(&bar[XB_XCNT(j)]) : "memory");
        asm volatile("s_waitcnt vmcnt(0)" : "+v"(cv[0]), "+v"(cv[1]), "+v"(cv[2]), "+v"(cv[3]), "+v"(cv[4]), "+v"(cv[5]), "+v"(cv[6]), "+v"(cv[7]),
                                            "+v"(cv[8]), "+v"(cv[9]), "+v"(cv[10]), "+v"(cv[11]), "+v"(cv[12]), "+v"(cv[13]), "+v"(cv[14]), "+v"(cv[15]) :: "memory");
#pragma unroll
        for (unsigned j = 0; j < 16; ++j) { const unsigned c = cv[j]; sum += c; cnt += (c > 0u) ? 1u : 0u; mine = (j == x) ? c : mine; }
        if (sum == G) break;
        __builtin_amdgcn_s_sleep(1);
        if ((++sp & 255u) == 0u) { if (xb_ld(&bar[XB_TMO])) break; if (sp > XB_SPIN_CAP) { atomicAdd(&bar[XB_TMO], 1u); break; } }
    }
    nloc = mine > 0u ? mine : 1u; nx = cnt > 0u ? cnt : 1u;
}

__device__ __forceinline__ void xcd_barrier(const XcdBarrier& b) {
    asm volatile("s_waitcnt vmcnt(0)" ::: "memory");
    __syncthreads();
    if (threadIdx.x == 0) {
        unsigned* bar = b.bar;
        __builtin_amdgcn_s_waitcnt(0);
        unsigned nloc = b.st[0], nx = b.st[1];
        if (nloc == 0u) { xcd_barrier_complete(bar, b.x, nloc, nx); b.st[0] = nloc; b.st[1] = nx; }
        const unsigned old = xb_add(&bar[XB_XSUB(b.x)], 1u);
        const unsigned gen = old / nloc;
        if (old + 1u == (gen + 1u) * nloc) {
            __builtin_amdgcn_fence(__ATOMIC_RELEASE, "agent");
            asm volatile("s_waitcnt vmcnt(0)" ::: "memory");
            const unsigned og = xb_add(&bar[XB_TOP], 1u);
            const unsigned tg = og / nx;
            if (og + 1u == (tg + 1u) * nx) xb_add(&bar[XB_TOPGEN], 1u);
            else XB_SPIN(xb_ld(&bar[XB_TOPGEN]) == tg, bar);
            __builtin_amdgcn_fence(__ATOMIC_ACQUIRE, "agent");
            xb_add(&bar[XB_XGEN(b.x)], 1u);
            asm volatile("s_waitcnt vmcnt(0)" ::: "memory");
        } else {
            XB_SPIN(xb_ld(&bar[XB_XGEN(b.x)]) == gen, bar);
            __builtin_amdgcn_fence(__ATOMIC_ACQUIRE, "agent");
            asm volatile("s_waitcnt vmcnt(0)" ::: "memory");
        }
    }
    __syncthreads();
}

__global__ void __launch_bounds__(512, 2) trunk_fwd(Args a) {
    extern __shared__ __attribute__((aligned(16))) unsigned char smem[];
    LAS unsigned char* lds = (LAS unsigned char*)smem;
    cg::grid_group grid = cg::this_grid();
    const int G = gridDim.x, bx = blockIdx.x;
    const int vcu = (G % 8 == 0) ? (bx % 8) * (G / 8) + bx / 8 : bx;
    unsigned char* ws = a.ws;
    float* H = (float*)(ws + WS_H);
    bf16* U = (bf16*)(ws + WS_U);
    bf16* PROJ = (bf16*)(ws + WS_PROJ);
    bf16* GB = (bf16*)(ws + WS_G);

    unsigned* barw = (unsigned*)(ws + WS_BAR);
    if (bx == 0) for (int i = threadIdx.x; i < CW_WORDS; i += 512) __hip_atomic_store(barw + i, 0u, __ATOMIC_RELAXED, __HIP_MEMORY_SCOPE_AGENT);
    volatile LAS unsigned* barst = (volatile LAS unsigned*)(lds + LDS_BARST);
    if (threadIdx.x < 2) barst[threadIdx.x] = 0u;
    p0_prologue(a, lds, G);
#if PROBE == 1
    __syncthreads(); p0_prologue(a, lds, G);
#endif
    __syncthreads();
    grid.sync();
    const XcdBarrier xbar = xcd_barrier_post(barw, barst);
#define GRID_SYNC() xcd_barrier(xbar)
    const bool fusedn = (G == 256);
#pragma unroll 1
    for (int layer = 0; layer < DEPTH; ++layer) {
        const float* hin = layer == 0 ? a.x : H;
        const float* mod = (const float*)(ws + WS_MOD) + (size_t)layer * NB * NMOD;
        if (layer == 0 || !fusedn) {
            rows_phase<false>(hin, a.norm_g + (size_t)layer * DM, mod, U, nullptr, G);
            GRID_SYNC();
        }
        {
            pg8::Gemm g{U, (const bf16*)(ws + WS_WIN) + (size_t)layer * PIN * DM, MTOK, PIN, DM};
            pg8::StaticOrder S; S.init(MTOK, PIN, G, bx);
            pg8::EpiProj E{PROJ, PINP, 48};
            pg8::gemm_phase<pg8::EpiProj, pg8::StaticOrder, false, true>(lds, g, S, E);
#if PROBE == 2
            __syncthreads(); pg8::gemm_phase<pg8::EpiProj, pg8::StaticOrder, false, true>(lds, g, S, E);
#endif
        }
        GRID_SYNC();
        for (int rep_ = 0; rep_ < ((PROBE == 3 && (layer & 1) == 0) || (PROBE == 4 && (layer & 1) == 1) ? 2 : 1); ++rep_)
        if ((layer & 1) == 0) {
#pragma unroll 1
            for (int pass = 0; pass < 2; ++pass) {
                if (((pass ^ (vcu >> 7)) & 1) == 0) { for (int u = vcu; u < 256; u += G) dilated_unit(a, lds, u >> 3, u & 7); }
                else { for (int p = vcu; p < 256; p += G) { diff_unit(a, lds, layer, p >> 3, p & 7); diff_unit(a, lds, layer, p >> 3, 15 - (p & 7)); } }
            }
        } else {
            for (int u = vcu; u < 1024; u += G) stick_unit(a, lds, u >> 4, u & 15);
        }
        __syncthreads();
        GRID_SYNC();
        {
            pg8::Gemm g{GB, (const bf16*)(ws + WS_WOUT) + (size_t)layer * DM * DI, MTOK, DM, DI};
            pg8::StaticOrder S; S.init(MTOK, DM, G, bx);
            if (fusedn) {
                const bool fin = layer == DEPTH - 1;
                pg8::EpiResNorm E{hin, H, mod + 2 * DM, DM, NMOD, SEQ, fin ? a.final_norm_g : a.norm_g + (size_t)(layer + 1) * DM, fin ? nullptr : mod + NB * NMOD, U, a.out,
                                  (float*)(ws + WS_SLOTS), barw + CW_PANEL + layer * 32 * 64, fin ? 1 : 0};
                pg8::gemm_phase<pg8::EpiResNorm, pg8::StaticOrder, false, true>(lds, g, S, E);
            } else {
                pg8::EpiRes E{hin, H, mod + 2 * DM, DM, NMOD, SEQ};
                pg8::gemm_phase<pg8::EpiRes, pg8::StaticOrder, true, true>(lds, g, S, E);
            }
        }
        if (layer + 1 < DEPTH || !fusedn) GRID_SYNC();
    }
    if (!fusedn) rows_phase<true>(H, a.final_norm_g, nullptr, nullptr, a.out, G);
}

extern "C" void kernel_launch(void* const* d_in, const int* in_sizes, int n_in, void* d_out, int out_size, void* d_ws, size_t ws_size, hipStream_t stream) {
    static int grid = 0;
    if (grid == 0) {
        if (n_in != 11 || out_size != MTOK * DM || ws_size < WS_END) { fprintf(stderr, "kernel_launch: unexpected shapes (n_in %d out %d ws %zu)\n", n_in, out_size, ws_size); grid = -1; return; }
        int dev = 0, cus = 0, per_cu = 0;
        (void)hipGetDevice(&dev);
        (void)hipDeviceGetAttribute(&cus, hipDeviceAttributeMultiprocessorCount, dev);
        (void)hipFuncSetAttribute((const void*)trunk_fwd, hipFuncAttributeMaxDynamicSharedMemorySize, LDS_BYTES);
        if (hipOccupancyMaxActiveBlocksPerMultiprocessor(&per_cu, (const void*)trunk_fwd, 512, LDS_BYTES) != hipSuccess || per_cu < 1) { fprintf(stderr, "kernel_launch: occupancy query says %d\n", per_cu); per_cu = 1; }
        (void)hipGetLastError();
        grid = cus * per_cu;
    }
    if (grid < 0) return;
    Args a{};
    a.x = (const float*)d_in[0]; a.c = (const float*)d_in[1]; a.norm_g = (const float*)d_in[2]; a.w_mod = (const float*)d_in[3]; a.b_mod = (const float*)d_in[4];
    a.w_in = (const float*)d_in[5]; a.w_out = (const float*)d_in[6]; a.rel_bias = (const float*)d_in[7]; a.diff_lambda = (const float*)d_in[8];
    a.diff_subln_g = (const float*)d_in[9]; a.final_norm_g = (const float*)d_in[10]; a.out = (float*)d_out; a.ws = (unsigned char*)d_ws;
    void* args[] = {&a};
    hipError_t e = hipLaunchCooperativeKernel((const void*)trunk_fwd, dim3(grid), dim3(512), args, LDS_BYTES, stream);
    if (e != hipSuccess) fprintf(stderr, "cooperative launch failed: %s (grid %d)\n", hipGetErrorString(e), grid);
}
```

```cpp
#include <hip/hip_runtime.h>
#include <hip/hip_cooperative_groups.h>
#include <cstdio>
#include <cstdint>
namespace cg = cooperative_groups;
#ifndef PROBE
#define PROBE 0
#endif
namespace pg8 {
#define PG8_LAS __attribute__((address_space(3)))
typedef unsigned short bf16_t;
typedef short bf16x8 __attribute__((ext_vector_type(8)));
typedef float f32x4 __attribute__((ext_vector_type(4)));
typedef unsigned u32x4 __attribute__((ext_vector_type(4)));
constexpr int BM = 256, BK = 64, HALF = 128, HTB = HALF * BK * 2  , STAGE_BYTES = 8 * HTB, NXCD = 8, WGM = 4;

__host__ __device__ __forceinline__ int lds_byte(int r, int c) { const int st = (r >> 4) * 2 + (c >> 5), rr = r & 15, cc = c & 31, ob = rr * 64 + cc * 2; return st * 1024 + (ob ^ (((ob >> 9) & 1) << 5)); }
__host__ __device__ __forceinline__ void stage_rc(int b, int& R, int& C) { const int st = b / 1024, sb = b % 1024, swz = sb ^ (((sb >> 9) & 1) << 5); R = (st >> 1) * 16 + swz / 64; C = (st & 1) * 32 + (swz % 64) / 2; }
__host__ __device__ __forceinline__ int perm32(int rho) { const int n = rho >> 4, i = rho & 15; return 8 * (i >> 2) + 4 * n + (i & 3); }

struct Unit { int pm, pn; };
struct Gemm { const bf16_t* A; const bf16_t* Bt; int M, N, K; };

struct StaticOrder {
    int nM, nN, nwg, G, c;
    __host__ __device__ void init(int M, int N, int G_, int c_) { nM = M / BM; nN = N / BM; nwg = nM * nN; G = G_; c = c_; }
    __host__ __device__ bool next(int i, Unit& u) const {
        const long L = (long)i * G + c; if (L >= nwg) return false;
        int wgid = (int)L; { const int q = nwg / NXCD, r = nwg % NXCD, xcd = wgid % NXCD, off = wgid / NXCD; wgid = (xcd < r ? xcd * (q + 1) : r * (q + 1) + (xcd - r) * q) + off; }
        const int nig = WGM * nN, gid = wgid / nig, fm = gid * WGM, gsz = (nM - fm) < WGM ? (nM - fm) : WGM;
        u.pm = fm + ((wgid % nig) % gsz); u.pn = (wgid % nig) / gsz; return true;
    }
    __device__ __forceinline__ void a_ready(const Unit&) const {}
    __device__ __forceinline__ void done(const Unit&) const {}
};

__device__ __forceinline__ unsigned cvt_pk_bf16(float lo, float hi) { unsigned r; asm volatile("v_cvt_pk_bf16_f32 %0, %1, %2" : "=v"(r) : "v"(lo), "v"(hi)); return r; }
typedef float f32x2 __attribute__((ext_vector_type(2)));

__device__ __forceinline__ float silu_f(float v) { return v * __builtin_amdgcn_rcpf(1.0f + __builtin_amdgcn_exp2f(v * -1.4426950408889634f)); }
struct EpiProj {
    static constexpr bool PERM = true, AFTER_DRAIN = false;
    bf16_t* O; int ldc; int act_pn0;
    __device__ __forceinline__ void operator()(const f32x4 (&acc)[2][2][4][2], const Unit& u, int wr, int wc, int fr, int fq) const {
        const int row0 = u.pm * BM + wr * 64 + fr; const int col0 = u.pn * BM + wc * 32 + 8 * fq;
        const bool act = u.pn >= act_pn0;
#pragma unroll
        for (int ai = 0; ai < 2; ++ai)
#pragma unroll
            for (int m = 0; m < 4; ++m) { bf16_t* rowp = O + (size_t)(row0 + ai * HALF + m * 16) * ldc + col0;
#pragma unroll
                for (int bj = 0; bj < 2; ++bj) { f32x4 v0 = acc[ai][bj][m][0], v1 = acc[ai][bj][m][1];
                    if (act) { v0 = (f32x4){silu_f(v0[0]), silu_f(v0[1]), silu_f(v0[2]), silu_f(v0[3])}; v1 = (f32x4){silu_f(v1[0]), silu_f(v1[1]), silu_f(v1[2]), silu_f(v1[3])}; }
                    u32x4 w; w.x = cvt_pk_bf16(v0[0], v0[1]); w.y = cvt_pk_bf16(v0[2], v0[3]); w.z = cvt_pk_bf16(v1[0], v1[1]); w.w = cvt_pk_bf16(v1[2], v1[3]);
                    *(u32x4*)(rowp + bj * HALF) = w; } }
    }
};
struct EpiRes {
    static constexpr bool PERM = false, AFTER_DRAIN = false;
    const float* hin; float* hout; const float* gate; int ldc; int gate_bstride; int rows_per_batch;
    __device__ __forceinline__ void operator()(const f32x4 (&acc)[2][2][4][2], const Unit& u, int wr, int wc, int fr, int fq) const {
        const int col0 = u.pn * BM + wc * 32 + 4 * fq; const int b = (u.pm * BM) / rows_per_batch;
        const float* gp = gate + (size_t)b * gate_bstride + col0;
#pragma unroll
        for (int bj = 0; bj < 2; ++bj)
#pragma unroll
            for (int n = 0; n < 2; ++n) { const f32x4 gv = *(const f32x4*)(gp + bj * HALF + n * 16);
#pragma unroll
                for (int ai = 0; ai < 2; ++ai)
#pragma unroll
                    for (int m = 0; m < 4; ++m) { const size_t off = (size_t)(u.pm * BM + ai * HALF + wr * 64 + m * 16 + fr) * ldc + col0 + bj * HALF + n * 16;
                        const f32x4 hv = *(const f32x4*)(hin + off); *(f32x4*)(hout + off) = hv + gv * acc[ai][bj][m][n]; } }
    }
};

struct EpiResNorm {
    static constexpr bool PERM = false, AFTER_DRAIN = true;
    const float* hin; float* hout; const float* gate; int ldc; int gate_bstride; int rows_per_batch;
    const float* ng; const float* nmod; bf16_t* uout; float* fout; float* slots; unsigned* cnt; int final_;
    __device__ __forceinline__ void fused(f32x4 (&acc)[2][2][4][2], const Unit& u, int wr, int wc, int fr, int fq, PG8_LAS unsigned char* lds, int wid, int lane) const {
        const int tid = wid * 64 + lane;
        const int col0 = u.pn * BM + wc * 32 + 4 * fq; const int b = (u.pm * BM) / rows_per_batch;
        const float* gp = gate + (size_t)b * gate_bstride + col0;
        PG8_LAS float* P = (PG8_LAS float*)lds;
        PG8_LAS float* S = (PG8_LAS float*)(lds + 4096);
#pragma unroll
        for (int bj = 0; bj < 2; ++bj)
#pragma unroll
            for (int n = 0; n < 2; ++n) { const f32x4 gv = *(const f32x4*)(gp + bj * HALF + n * 16);
                f32x4 hv8[2][4];
#pragma unroll
                for (int ai = 0; ai < 2; ++ai)
#pragma unroll
                    for (int m = 0; m < 4; ++m) hv8[ai][m] = *(const f32x4*)(hin + (size_t)(u.pm * BM + ai * HALF + wr * 64 + m * 16 + fr) * ldc + col0 + bj * HALF + n * 16);
                asm volatile("" : "+v"(hv8[0][0]), "+v"(hv8[0][1]), "+v"(hv8[0][2]), "+v"(hv8[0][3]), "+v"(hv8[1][0]), "+v"(hv8[1][1]), "+v"(hv8[1][2]), "+v"(hv8[1][3]));
#pragma unroll
                for (int ai = 0; ai < 2; ++ai)
#pragma unroll
                    for (int m = 0; m < 4; ++m) { const size_t off = (size_t)(u.pm * BM + ai * HALF + wr * 64 + m * 16 + fr) * ldc + col0 + bj * HALF + n * 16;
                        const f32x4 hv = hv8[ai][m] + gv * acc[ai][bj][m][n]; acc[ai][bj][m][n] = hv;
                        if (!final_) *(f32x4*)(hout + off) = hv; } }
#pragma unroll
        for (int ai = 0; ai < 2; ++ai)
#pragma unroll
            for (int m = 0; m < 4; ++m) { float q = 0.f;
#pragma unroll
                for (int bj = 0; bj < 2; ++bj)
#pragma unroll
                    for (int n = 0; n < 2; ++n) { const f32x4 x = acc[ai][bj][m][n]; q += (x[0] * x[0] + x[1] * x[1]) + (x[2] * x[2] + x[3] * x[3]); }
                q += __shfl_xor(q, 16); q += __shfl_xor(q, 32);
                if (fq == 0) P[(ai * HALF + wr * 64 + m * 16 + fr) * 4 + wc] = q; }
        asm volatile("s_waitcnt lgkmcnt(0)" ::: "memory"); __builtin_amdgcn_s_barrier(); asm volatile("" ::: "memory");
        if (tid < BM) { const float t = (P[tid * 4 + 0] + P[tid * 4 + 1]) + (P[tid * 4 + 2] + P[tid * 4 + 3]);
            __hip_atomic_store(slots + (size_t)(u.pm * BM + tid) * 8 + u.pn, t, __ATOMIC_RELAXED, __HIP_MEMORY_SCOPE_AGENT); }
        asm volatile("s_waitcnt vmcnt(0)" ::: "memory"); __builtin_amdgcn_s_barrier(); asm volatile("" ::: "memory");
        if (tid == 0) { __hip_atomic_fetch_add(cnt + 64 * u.pm, 1u, __ATOMIC_RELAXED, __HIP_MEMORY_SCOPE_AGENT);
            unsigned spins = 0u;
            while (__hip_atomic_load(cnt + 64 * u.pm, __ATOMIC_RELAXED, __HIP_MEMORY_SCOPE_AGENT) < 8u) { __builtin_amdgcn_s_sleep(2); if (++spins > (1u << 22)) break; }
            __builtin_amdgcn_fence(__ATOMIC_ACQUIRE, "agent"); }
        asm volatile("s_waitcnt vmcnt(0) lgkmcnt(0)" ::: "memory"); __builtin_amdgcn_s_barrier(); asm volatile("" ::: "memory");
        if (tid < BM) { const float* sl = slots + (size_t)(u.pm * BM + tid) * 8; float t = 0.f;
#pragma unroll
            for (int k = 0; k < 8; ++k) t += __hip_atomic_load(sl + k, __ATOMIC_RELAXED, __HIP_MEMORY_SCOPE_AGENT);
            S[tid] = 1.0f / sqrtf(t * (1.0f / 2048.0f) + 1e-6f); }
        asm volatile("s_waitcnt vmcnt(0) lgkmcnt(0)" ::: "memory"); __builtin_amdgcn_s_barrier(); asm volatile("" ::: "memory");
#pragma unroll
        for (int bj = 0; bj < 2; ++bj)
#pragma unroll
            for (int n = 0; n < 2; ++n) { const int c = col0 + bj * HALF + n * 16; const f32x4 g4 = *(const f32x4*)(ng + c);
                f32x4 sc4 = {0.f, 0.f, 0.f, 0.f}, sh4 = {0.f, 0.f, 0.f, 0.f};
                if (!final_) { sh4 = *(const f32x4*)(nmod + (size_t)b * gate_bstride + c); sc4 = *(const f32x4*)(nmod + (size_t)b * gate_bstride + 2048 + c); }
#pragma unroll
                for (int ai = 0; ai < 2; ++ai)
#pragma unroll
                    for (int m = 0; m < 4; ++m) { const int r = ai * HALF + wr * 64 + m * 16 + fr; const float rs = S[r]; const size_t off = (size_t)(u.pm * BM + r) * ldc + c;
                        f32x4 y = acc[ai][bj][m][n] * rs * g4;
                        if (final_) *(f32x4*)(fout + off) = y;
                        else { y = y * (sc4 + 1.0f) + sh4; typedef unsigned u32x2_ __attribute__((ext_vector_type(2))); u32x2_ w; w.x = cvt_pk_bf16(y[0], y[1]); w.y = cvt_pk_bf16(y[2], y[3]); *(u32x2_*)(uout + off) = w; } } }
    }
};
template <class Epi, class Sched, bool ALIGN_EPI = false, bool SP2 = false>
__device__ __forceinline__ void gemm_phase(PG8_LAS unsigned char* lds, const Gemm g, const Sched& S, const Epi& E) {
    int tid0_ = threadIdx.x; asm volatile("" : "+v"(tid0_));
    const int tid = tid0_, wid = __builtin_amdgcn_readfirstlane(tid >> 6), lane = tid & 63, wr = wid >> 2, wc = wid & 3, fr = lane & 15, fq = lane >> 4;
    const int K = g.K, nt = K / BK;
    unsigned voffA[2], voffB[2];
#pragma unroll
    for (int i = 0; i < 2; ++i) { int R, C; stage_rc(tid * 16 + i * 8192, R, C); const int Rb = Epi::PERM ? ((R & ~31) + perm32(R & 31)) : R;
        voffA[i] = (unsigned)(R * K + C) * 2u; voffB[i] = (unsigned)(Rb * K + C) * 2u; }
    const size_t kstep = (size_t)(BK * 2);
    const size_t hstep = (size_t)HALF * K * 2;
    const size_t tstep = 2 * hstep;
    const unsigned ldsw = (unsigned)wid * 1024u;
    const int aoff = lds_byte(wr * 64 + fr, fq * 8), boff = lds_byte(wc * 32 + fr, fq * 8);
#define PG8_SA(b, h) (((b) * 2 + (h)) * HTB)
#define PG8_SB(b, h) ((4 + (b) * 2 + (h)) * HTB)
#define PG8_STAGE(bufoff, gbase, voff) do { _Pragma("unroll") for (int _i = 0; _i < 2; ++_i) \
        __builtin_amdgcn_global_load_lds((const unsigned*)((const char*)(gbase) + (voff)[_i]), (PG8_LAS unsigned*)(lds + (bufoff) + ldsw + _i * 8192), 16, 0, 0); } while (0)
#define PG8_LDA(dst, b, h) do { _Pragma("unroll") for (int m = 0; m < 4; ++m) _Pragma("unroll") for (int k = 0; k < 2; ++k) dst[m][k] = *(const PG8_LAS bf16x8*)(lds + PG8_SA(b, h) + aoff + m * 2048 + k * 1024); } while (0)
#define PG8_LDB(dst, b, h) do { _Pragma("unroll") for (int n = 0; n < 2; ++n) _Pragma("unroll") for (int k = 0; k < 2; ++k) dst[n][k] = *(const PG8_LAS bf16x8*)(lds + PG8_SB(b, h) + boff + n * 2048 + k * 1024); } while (0)
#define PG8_MMA(ai, bj, At, Bt) do { __builtin_amdgcn_s_setprio(1); _Pragma("unroll") for (int m = 0; m < 4; ++m) _Pragma("unroll") for (int n = 0; n < 2; ++n) _Pragma("unroll") for (int k = 0; k < 2; ++k) \
        acc[ai][bj][m][n] = __builtin_amdgcn_mfma_f32_16x16x32_bf16(Bt[n][k], At[m][k], acc[ai][bj][m][n], 0, 0, 0); __builtin_amdgcn_s_setprio(0); } while (0)
#define PG8_WAIT_V(n) asm volatile("s_waitcnt vmcnt(" #n ")" ::: "memory")
#define PG8_WAIT_L(n) asm volatile("s_waitcnt lgkmcnt(" #n ")" ::: "memory")
#define PG8_BAR __builtin_amdgcn_s_barrier()
#define PG8_SCHED __builtin_amdgcn_sched_barrier(0)
    Unit cur, nxt; int ui = 0;
    if (!S.next(0, cur)) return;
    f32x4 acc[2][2][4][2];
#pragma unroll
    for (int a = 0; a < 2; ++a)
#pragma unroll
        for (int b = 0; b < 2; ++b)
#pragma unroll
            for (int m = 0; m < 4; ++m)
#pragma unroll
                for (int n = 0; n < 2; ++n) acc[a][b][m][n] = (f32x4){0.f, 0.f, 0.f, 0.f};
    bf16x8 At[4][2], B0[2][2], B1[2][2];
    const char* cA = (const char*)g.A + (size_t)cur.pm * tstep; const char* cB = (const char*)g.Bt + (size_t)cur.pn * tstep;
    S.a_ready(cur);
    if constexpr (SP2) {
        PG8_STAGE(PG8_SB(0, 0), cB, voffB); PG8_STAGE(PG8_SB(0, 1), cB + hstep, voffB); PG8_STAGE(PG8_SA(0, 0), cA, voffA); PG8_STAGE(PG8_SA(0, 1), cA + hstep, voffA);
        if (wr == 1) PG8_BAR;
        PG8_WAIT_V(2); PG8_BAR;
        PG8_STAGE(PG8_SB(1, 0), cB + kstep, voffB); PG8_STAGE(PG8_SA(1, 0), cA + kstep, voffA); PG8_STAGE(PG8_SB(1, 1), cB + hstep + kstep, voffB);
        PG8_WAIT_V(6); PG8_BAR;
    } else {
        PG8_STAGE(PG8_SB(0, 0), cB, voffB); PG8_STAGE(PG8_SA(0, 0), cA, voffA); PG8_STAGE(PG8_SB(0, 1), cB + hstep, voffB); PG8_STAGE(PG8_SA(0, 1), cA + hstep, voffA);
        if (wr == 1) PG8_BAR;
        PG8_WAIT_V(4); PG8_BAR;
        PG8_STAGE(PG8_SB(1, 0), cB + kstep, voffB); PG8_STAGE(PG8_SA(1, 0), cA + kstep, voffA); PG8_STAGE(PG8_SB(1, 1), cB + hstep + kstep, voffB);
        PG8_WAIT_V(6); PG8_BAR;
    }
    for (;;) {
        const bool has_next = S.next(ui + 1, nxt);
        const char* nA = has_next ? (const char*)g.A + (size_t)nxt.pm * tstep : cA; const char* nB = has_next ? (const char*)g.Bt + (size_t)nxt.pn * tstep : cB;
        for (int t = 0; t < nt; t += 2) {
            const bool last = (t == nt - 2);
            const char* a1 = cA + (size_t)(t + 1) * kstep;
            const char* a2 = last ? nA : cA + (size_t)(t + 2) * kstep; const char* b2 = last ? nB : cB + (size_t)(t + 2) * kstep;
            const char* a3 = a2 + kstep; const char* b3 = b2 + kstep;
            if (last && has_next) S.a_ready(nxt);
            if constexpr (SP2) {
            PG8_LDB(B0, 0, 0); PG8_LDB(B1, 0, 1); PG8_SCHED; PG8_LDA(At, 0, 0); PG8_STAGE(PG8_SA(1, 1), a1 + hstep, voffA);
            PG8_WAIT_V(8); PG8_WAIT_L(0); PG8_BAR; PG8_MMA(0, 0, At, B0); PG8_MMA(0, 1, At, B1); PG8_BAR; PG8_SCHED;
            PG8_LDA(At, 0, 1); PG8_STAGE(PG8_SB(0, 0), b2, voffB); PG8_STAGE(PG8_SB(0, 1), b2 + hstep, voffB); PG8_STAGE(PG8_SA(0, 0), a2, voffA);
            PG8_WAIT_V(8); PG8_WAIT_L(0); PG8_BAR; PG8_MMA(1, 0, At, B0); PG8_MMA(1, 1, At, B1); PG8_BAR; PG8_SCHED;
            PG8_LDB(B0, 1, 0); PG8_LDB(B1, 1, 1); PG8_SCHED; PG8_LDA(At, 1, 0); PG8_STAGE(PG8_SA(0, 1), a2 + hstep, voffA);
            PG8_WAIT_V(8); PG8_WAIT_L(0); PG8_BAR; PG8_MMA(0, 0, At, B0); PG8_MMA(0, 1, At, B1); PG8_BAR; PG8_SCHED;
            PG8_LDA(At, 1, 1); PG8_STAGE(PG8_SB(1, 0), b3, voffB); PG8_STAGE(PG8_SB(1, 1), b3 + hstep, voffB); PG8_STAGE(PG8_SA(1, 0), a3, voffA);
            PG8_WAIT_V(8); PG8_WAIT_L(0); PG8_BAR; PG8_MMA(1, 0, At, B0); PG8_MMA(1, 1, At, B1); PG8_BAR; PG8_SCHED;
            } else {
            PG8_LDB(B0, 0, 0); PG8_SCHED; PG8_LDA(At, 0, 0); PG8_STAGE(PG8_SA(1, 1), a1 + hstep, voffA);
            PG8_WAIT_L(8); PG8_BAR; PG8_WAIT_L(0); PG8_MMA(0, 0, At, B0); PG8_BAR; PG8_SCHED;
            PG8_LDB(B1, 0, 1); PG8_STAGE(PG8_SB(0, 0), b2, voffB);
            PG8_BAR; PG8_WAIT_L(0); PG8_MMA(0, 1, At, B1); PG8_BAR;
            PG8_LDA(At, 0, 1); PG8_STAGE(PG8_SA(0, 0), a2, voffA);
            PG8_BAR; PG8_WAIT_L(0); PG8_MMA(1, 0, At, B0); PG8_BAR; PG8_SCHED;
            PG8_STAGE(PG8_SB(0, 1), b2 + hstep, voffB);
            PG8_WAIT_V(6); PG8_BAR; PG8_MMA(1, 1, At, B1); PG8_BAR;
            PG8_LDB(B0, 1, 0); PG8_SCHED; PG8_LDA(At, 1, 0); PG8_STAGE(PG8_SA(0, 1), a2 + hstep, voffA);
            PG8_WAIT_L(8); PG8_BAR; PG8_WAIT_L(0); PG8_MMA(0, 0, At, B0); PG8_BAR; PG8_SCHED;
            PG8_LDB(B1, 1, 1); PG8_STAGE(PG8_SB(1, 0), b3, voffB);
            PG8_BAR; PG8_WAIT_L(0); PG8_MMA(0, 1, At, B1); PG8_BAR;
            PG8_LDA(At, 1, 1); PG8_STAGE(PG8_SA(1, 0), a3, voffA);
            PG8_BAR; PG8_WAIT_L(0); PG8_MMA(1, 0, At, B0); PG8_BAR; PG8_SCHED;
            PG8_STAGE(PG8_SB(1, 1), b3 + hstep, voffB);
            PG8_WAIT_V(6); PG8_BAR; PG8_MMA(1, 1, At, B1); PG8_BAR;
            }
        }
        if constexpr (ALIGN_EPI) { if (wr == 0) PG8_BAR; }
        if constexpr (!Epi::AFTER_DRAIN) { E(acc, cur, wr, wc, fr, fq); S.done(cur); }
        if (!has_next) break;
#pragma unroll
        for (int a = 0; a < 2; ++a)
#pragma unroll
            for (int b = 0; b < 2; ++b)
#pragma unroll
                for (int m = 0; m < 4; ++m)
#pragma unroll
                    for (int n = 0; n < 2; ++n) acc[a][b][m][n] = (f32x4){0.f, 0.f, 0.f, 0.f};
        cur = nxt; cA = nA; cB = nB; ++ui;
        if constexpr (ALIGN_EPI) { if (wr == 1) PG8_BAR; }
    }
    PG8_WAIT_V(0);
    if constexpr (!ALIGN_EPI) { if (wr == 0) PG8_BAR; }
    PG8_BAR;
    if constexpr (Epi::AFTER_DRAIN) { E.fused(acc, cur, wr, wc, fr, fq, lds, wid, lane); S.done(cur); }
#undef PG8_SA
#undef PG8_SB
#undef PG8_STAGE
#undef PG8_LDA
#undef PG8_LDB
#undef PG8_MMA
#undef PG8_WAIT_V
#undef PG8_WAIT_L
#undef PG8_BAR
#undef PG8_SCHED
}
}

constexpr int NB = 2, SEQ = 4096, DM = 2048, MTOK = NB * SEQ, DI = 4096, PIN = 16384, PINP = PIN + 128  , DEPTH = 4, NMOD = 3 * DM;
constexpr float EPS = 1e-6f, LOG2E = 1.4426950408889634f, LN2 = 0.6931471805599453f;
constexpr size_t MiB = 1u << 20;
constexpr size_t WS_WIN = 0, WS_WOUT = 256 * MiB, WS_U = 320 * MiB, WS_PROJ = 352 * MiB, WS_G = 612 * MiB, WS_H = 676 * MiB,
                 WS_MOD = 740 * MiB, WS_LSE = 741 * MiB, WS_OG = 744 * MiB, WS_BAR = 840 * MiB, WS_END = 841 * MiB;
static_assert(WS_PROJ + (size_t)MTOK * PINP * 2 <= WS_G, "ws map");
constexpr int LDS_BYTES = 158720, LDS_BARST = 158656;
constexpr int CW_PANEL = 4096  , CW_WORDS = CW_PANEL + DEPTH * 32 * 64;
constexpr size_t WS_SLOTS = WS_BAR + 512 * 1024;

#define GAS __attribute__((address_space(1)))
#define LAS __attribute__((address_space(3)))
typedef unsigned short bf16;
typedef unsigned v4u __attribute__((ext_vector_type(4)));
typedef unsigned v2u __attribute__((ext_vector_type(2)));
typedef float f32x4 __attribute__((ext_vector_type(4)));
typedef float f32x16 __attribute__((ext_vector_type(16)));
typedef short bf16x8 __attribute__((ext_vector_type(8)));
typedef short s16x4 __attribute__((ext_vector_type(4)));
#define LDS_WAIT() asm volatile("s_waitcnt lgkmcnt(0)" ::: "memory")
__device__ __forceinline__ unsigned f2bf(float f) { unsigned u = __builtin_bit_cast(unsigned, f); return (u + 0x7fffu + ((u >> 16) & 1u)) >> 16; }
__device__ __forceinline__ unsigned pk2(float lo, float hi) { return f2bf(lo) | (f2bf(hi) << 16); }
__device__ __forceinline__ float bf2f(unsigned short h) { return __builtin_bit_cast(float, (unsigned)h << 16); }
__device__ __forceinline__ float bflo(unsigned w) { return __builtin_bit_cast(float, w << 16); }
__device__ __forceinline__ float bfhi(unsigned w) { return __builtin_bit_cast(float, w & 0xffff0000u); }
typedef float f32x2_t __attribute__((ext_vector_type(2))); typedef __bf16 bf16x2_t __attribute__((ext_vector_type(2)));
__device__ __forceinline__ unsigned cvtpk(float lo, float hi) { f32x2_t v = {lo, hi}; bf16x2_t b = __builtin_convertvector(v, bf16x2_t); return __builtin_bit_cast(unsigned, b); }
__device__ __forceinline__ float wave_sum(float v) {
#pragma unroll
    for (int o = 1; o < 64; o <<= 1) v += __shfl_xor(v, o);
    return v;
}
__device__ __forceinline__ float xpartner(float v, int hi) { auto rr = __builtin_amdgcn_permlane32_swap(__float_as_uint(v), __float_as_uint(v), false, false); return __uint_as_float(hi ? rr[0] : rr[1]); }
__device__ __forceinline__ float xmax(float v) { auto rr = __builtin_amdgcn_permlane32_swap(__float_as_uint(v), __float_as_uint(v), false, false); return fmaxf(__uint_as_float(rr[0]), __uint_as_float(rr[1])); }
__device__ __forceinline__ float xsum(float v) { auto rr = __builtin_amdgcn_permlane32_swap(__float_as_uint(v), __float_as_uint(v), false, false); return __uint_as_float(rr[0]) + __uint_as_float(rr[1]); }
__device__ __forceinline__ int crow(int r, int hi) { return (r & 3) + 8 * (r >> 2) + 4 * hi; }
__device__ __forceinline__ float silu(float v) { return v / (1.0f + __expf(-v)); }
__device__ __forceinline__ int t5_bucket(int rel) {
    if (rel < 16) return rel < 0 ? 0 : rel;
    int bk = 16;
    bk += rel >= 22; bk += rel >= 30; bk += rel >= 40; bk += rel >= 54; bk += rel >= 73; bk += rel >= 99; bk += rel >= 134; bk += rel >= 182;
    bk += rel >= 246; bk += rel >= 332; bk += rel >= 450; bk += rel >= 609; bk += rel >= 825; bk += rel >= 1117; bk += rel >= 1513;
    return bk;
}
__device__ __forceinline__ s16x4 vtr(const LAS char* p) { return __builtin_bit_cast(s16x4, __builtin_amdgcn_ds_read_tr16_b64_v4i16((LAS s16x4*)p)); }
#define MFMA32(a, b, c) __builtin_amdgcn_mfma_f32_32x32x16_bf16((a), (b), (c), 0, 0, 0)

__device__ __forceinline__ int opaque_tid() { int t = threadIdx.x; asm volatile("" : "+v"(t)); return t; }
struct Args { const float *x, *c, *norm_g, *w_mod, *b_mod, *w_in, *w_out, *rel_bias, *diff_lambda, *diff_subln_g, *final_norm_g; float* out; unsigned char* ws; };

__device__ __forceinline__ void p0_transpose_item(const float* W, int K, int N, bf16* WT, int row_off, LAS float* scr, int item, int lane) {
    const int nblk = N / 32, kb = item / nblk, nb = item % nblk, k0 = 64 * kb, n0 = 32 * nb;
#pragma unroll 8
    for (int i = 0; i < 32; ++i) { const int kk = 2 * i + (lane >> 5); scr[kk * 33 + (lane & 31)] = W[(size_t)(k0 + kk) * N + n0 + (lane & 31)]; }
    LDS_WAIT(); asm volatile("" ::: "memory");
    const int c = lane & 7;
#pragma unroll
    for (int j = 0; j < 4; ++j) { const int n = (lane >> 3) + 8 * j; const LAS float* s = scr + (8 * c) * 33 + n;
        v4u o; o.x = pk2(s[0 * 33], s[1 * 33]); o.y = pk2(s[2 * 33], s[3 * 33]); o.z = pk2(s[4 * 33], s[5 * 33]); o.w = pk2(s[6 * 33], s[7 * 33]);
        *(GAS v4u*)(WT + (size_t)(row_off + n0 + n) * K + k0 + 8 * c) = o; }
    LDS_WAIT(); asm volatile("" ::: "memory");
}
__device__ __forceinline__ void p0_prologue(const Args& a, LAS unsigned char* lds, int G) {
    const int tid = opaque_tid(), lane = tid & 63, wave = tid >> 6;
    LAS float* cs = (LAS float*)lds;
    LAS float* red = (LAS float*)(lds + 16384);
    float* MOD = (float*)(a.ws + WS_MOD);
    for (int i = tid; i < NB * DM; i += 512) cs[i] = silu(a.c[i]);
    __syncthreads();
    for (int item = blockIdx.x; item < DEPTH * (NMOD / 64); item += G) {
        const int l = item / (NMOD / 64), n0 = (item % (NMOD / 64)) * 64, kq = tid >> 4, cq = tid & 15;
        const float* W = a.w_mod + (size_t)l * DM * NMOD + n0 + 4 * cq;
        f32x4 a0 = {0.f, 0.f, 0.f, 0.f}, a1 = {0.f, 0.f, 0.f, 0.f};
#pragma unroll 8
        for (int k = kq; k < DM; k += 32) { const f32x4 w = *(const f32x4*)(W + (size_t)k * NMOD); a0 += w * cs[k]; a1 += w * cs[DM + k]; }
        *(LAS f32x4*)(red + (kq * 2 + 0) * 64 + 4 * cq) = a0; *(LAS f32x4*)(red + (kq * 2 + 1) * 64 + 4 * cq) = a1;
        __syncthreads();
        if (tid < 128) { const int b = tid >> 6, col = tid & 63; float s = 0.f;
#pragma unroll 8
            for (int q = 0; q < 32; ++q) s += red[(q * 2 + b) * 64 + col];
            MOD[((size_t)l * NB + b) * NMOD + n0 + col] = s + a.b_mod[(size_t)l * NMOD + n0 + col]; }
        __syncthreads();
    }
    __syncthreads();
    LAS float* scr = (LAS float*)(lds + wave * 16384);
    const int gw = blockIdx.x * 8 + wave, NGW = G * 8;
    constexpr int I_IN = (DM / 64) * (PIN / 32), I_OUT = (DI / 64) * (DM / 32);
    for (int it = gw; it < DEPTH * (I_IN + I_OUT); it += NGW) {
        const int l = it / (I_IN + I_OUT); int r = it % (I_IN + I_OUT);
        if (r < I_IN) p0_transpose_item(a.w_in + (size_t)l * DM * PIN, DM, PIN, (bf16*)(a.ws + WS_WIN) + (size_t)l * PIN * DM, 0, scr, r, lane);
        else p0_transpose_item(a.w_out + (size_t)l * DI * DM, DI, DM, (bf16*)(a.ws + WS_WOUT) + (size_t)l * DM * DI, 0, scr, r - I_IN, lane);
    }
}

template <bool FINAL> __device__ __forceinline__ void rows_phase(const float* hin, const float* g, const float* mod, bf16* uout, float* fout, int G) {
    const int tid = opaque_tid(), lane = tid & 63, gw = blockIdx.x * 8 + (tid >> 6), NGW = G * 8;
    for (int m = gw; m < MTOK; m += NGW) {
        const f32x4* xr = (const f32x4*)(hin + (size_t)m * DM) + lane;
        f32x4 v[8]; float s = 0.f;
#pragma unroll
        for (int j = 0; j < 8; ++j) { v[j] = xr[64 * j]; s += (v[j].x * v[j].x + v[j].y * v[j].y) + (v[j].z * v[j].z + v[j].w * v[j].w); }
        const float rstd = 1.0f / sqrtf(wave_sum(s) * (1.0f / DM) + EPS);
        const int b = m / SEQ;
#pragma unroll
        for (int j = 0; j < 8; ++j) {
            const int col = 4 * lane + 256 * j;
            const f32x4 gv = *(const f32x4*)(g + col);
            f32x4 y = v[j] * rstd * gv;
            if (FINAL) { *((f32x4*)(fout + (size_t)m * DM + col)) = y; }
            else {
                const f32x4 sh = *(const f32x4*)(mod + (size_t)b * NMOD + col), sc = *(const f32x4*)(mod + (size_t)b * NMOD + DM + col);
                y = y * (sc + 1.0f) + sh;
                v2u o; o.x = pk2(y.x, y.y); o.y = pk2(y.z, y.w);
                *(v2u*)(uout + (size_t)m * DM + col) = o;
            }
        }
    }
}

constexpr int VSTR = 320;
constexpr int KSTR = 272;
constexpr int K64STR = 144;
__device__ __forceinline__ void pv32(f32x16 (&o)[4], const LAS char* vt, bf16x8 pb0, bf16x8 pb1) {
#pragma unroll
    for (int c = 0; c < 4; ++c) {
        const s16x4 l0 = vtr(vt + c * 64), h0 = vtr(vt + 8 * VSTR + c * 64), l1 = vtr(vt + 16 * VSTR + c * 64), h1 = vtr(vt + 24 * VSTR + c * 64);
        const bf16x8 a0 = {l0[0], l0[1], l0[2], l0[3], h0[0], h0[1], h0[2], h0[3]}, a1 = {l1[0], l1[1], l1[2], l1[3], h1[0], h1[1], h1[2], h1[3]};
        o[c] = MFMA32(a0, pb0, o[c]); o[c] = MFMA32(a1, pb1, o[c]);
    }
}
__device__ __forceinline__ void pv32x2(f32x16 (&o1)[4], f32x16 (&o2)[4], const LAS char* vt, bf16x8 p1b0, bf16x8 p1b1, bf16x8 p2b0, bf16x8 p2b1) {
#pragma unroll
    for (int c = 0; c < 4; ++c) {
        const s16x4 l0 = vtr(vt + c * 64), h0 = vtr(vt + 8 * VSTR + c * 64), l1 = vtr(vt + 16 * VSTR + c * 64), h1 = vtr(vt + 24 * VSTR + c * 64);
        const bf16x8 a0 = {l0[0], l0[1], l0[2], l0[3], h0[0], h0[1], h0[2], h0[3]}, a1 = {l1[0], l1[1], l1[2], l1[3], h1[0], h1[1], h1[2], h1[3]};
        o1[c] = MFMA32(a0, p1b0, o1[c]); o1[c] = MFMA32(a1, p1b1, o1[c]);
        o2[c] = MFMA32(a0, p2b0, o2[c]); o2[c] = MFMA32(a1, p2b1, o2[c]);
    }
}

__device__ __forceinline__ void pv32s(f32x16 (&o)[4], const LAS char* vt, int xq, bf16x8 pb0, bf16x8 pb1) {
    __builtin_amdgcn_s_setprio(1);
#pragma unroll
    for (int c = 0; c < 4; ++c) {
        const LAS char* vc = vt + ((64 * c) ^ xq);
        const s16x4 l0 = vtr(vc), h0 = vtr(vc + 8 * 256), l1 = vtr(vc + 16 * 256), h1 = vtr(vc + 24 * 256);
        const bf16x8 a0 = {l0[0], l0[1], l0[2], l0[3], h0[0], h0[1], h0[2], h0[3]}, a1 = {l1[0], l1[1], l1[2], l1[3], h1[0], h1[1], h1[2], h1[3]};
        o[c] = MFMA32(a0, pb0, o[c]); o[c] = MFMA32(a1, pb1, o[c]);
    }
    __builtin_amdgcn_s_setprio(0);
}
__device__ __forceinline__ void pv32x2s(f32x16 (&o1)[4], f32x16 (&o2)[4], const LAS char* vt, int xq, bf16x8 p1b0, bf16x8 p1b1, bf16x8 p2b0, bf16x8 p2b1) {
#pragma unroll
    for (int c = 0; c < 4; ++c) {
        const LAS char* vc = vt + ((64 * c) ^ xq);
        const s16x4 l0 = vtr(vc), h0 = vtr(vc + 8 * 256), l1 = vtr(vc + 16 * 256), h1 = vtr(vc + 24 * 256);
        const bf16x8 a0 = {l0[0], l0[1], l0[2], l0[3], h0[0], h0[1], h0[2], h0[3]}, a1 = {l1[0], l1[1], l1[2], l1[3], h1[0], h1[1], h1[2], h1[3]};
        o1[c] = MFMA32(a0, p1b0, o1[c]); o1[c] = MFMA32(a1, p1b1, o1[c]);
        o2[c] = MFMA32(a0, p2b0, o2[c]); o2[c] = MFMA32(a1, p2b1, o2[c]);
    }
}
__device__ __forceinline__ void glds16(const void* gsrc, unsigned lds_dst) { unsigned keep;
    asm volatile("s_mov_b32 %0, m0\n\ts_mov_b32 m0, %2\n\ts_nop 0\n\tglobal_load_lds_dwordx4 %1, off\n\ts_mov_b32 m0, %0" : "=&s"(keep) : "v"(gsrc), "s"(lds_dst) : "memory"); }
#define GLDS16(gsrc, ldsdst) glds16((const void*)(gsrc), (unsigned)__builtin_amdgcn_readfirstlane((int)(unsigned)(size_t)(ldsdst)))
template <int THR> __device__ __forceinline__ void softmax_block(f32x16& s, float& m, float& l, f32x16 (&o)[4], bf16x8& pb0, bf16x8& pb1) {
    float mx = fmaxf(fmaxf(s[0], s[1]), s[2]);
#pragma unroll
    for (int r = 3; r < 15; r += 2) mx = fmaxf(fmaxf(mx, s[r]), s[r + 1]);
    mx = fmaxf(mx, s[15]);
    mx = xmax(mx);
    if (__any(mx > m + (float)THR)) {
        const float mn = fmaxf(m, mx);
        const float al = __builtin_amdgcn_exp2f(m - mn); l *= al;
#pragma unroll
        for (int c = 0; c < 4; ++c)
#pragma unroll
            for (int r = 0; r < 16; ++r) o[c][r] *= al;
        m = mn;
    }
    float sum = 0.f;
#pragma unroll
    for (int r = 0; r < 16; ++r) { s[r] = __builtin_amdgcn_exp2f(s[r] - m); sum += s[r]; }
    l += sum;
    v4u w0, w1;
    w0.x = cvtpk(s[0], s[1]); w0.y = cvtpk(s[2], s[3]); w0.z = cvtpk(s[4], s[5]); w0.w = cvtpk(s[6], s[7]);
    w1.x = cvtpk(s[8], s[9]); w1.y = cvtpk(s[10], s[11]); w1.z = cvtpk(s[12], s[13]); w1.w = cvtpk(s[14], s[15]);
    pb0 = __builtin_bit_cast(bf16x8, w0); pb1 = __builtin_bit_cast(bf16x8, w1);
}


__device__ __forceinline__ void k_load(const bf16* proj, int tk0, int d, int kcol, int r32, int hi, bf16x8 (&kf)[8]) {
    const int tk = max(tk0 + d * r32, 0); const bf16* kp = proj + (size_t)tk * PINP + kcol + hi * 8;
#pragma unroll
    for (int ss = 0; ss < 8; ++ss) kf[ss] = *(const bf16x8*)(kp + 16 * ss);
}
__device__ __forceinline__ void v_dma(const bf16* proj, int tk0, int d, int vcol, int lane, LAS unsigned char* vbuf) {
    const int c = (lane & 15) ^ (((lane >> 4) & 3) << 2);
#pragma unroll
    for (int i = 0; i < 8; ++i) { const int tk = max(tk0 + d * (4 * i + (lane >> 4)), 0);
        GLDS16(proj + (size_t)tk * PINP + vcol + c * 8, vbuf + i * 1024); }
}

constexpr int DF_TBLN = 1664;
constexpr int DF_TBL = 0, DF_BUF = 6656, DF_BUFB = 32768  , DF_Q = DF_BUF + 2 * DF_BUFB, DF_QW = 32 * KSTR  ;
static_assert(DF_Q + 8 * DF_QW <= LDS_BARST, "diff attention LDS map");
__device__ __forceinline__ void diff_unit(const Args& a, LAS unsigned char* lds, int layer, int bh, int qb) {
    const int tid = opaque_tid(), lane = tid & 63, r32 = lane & 31, hi = lane >> 5, wave = __builtin_amdgcn_readfirstlane(tid >> 6);
    const int b = bh >> 4, h = bh & 15, e = layer >> 1;
    const bf16* proj = (const bf16*)(a.ws + WS_PROJ) + (size_t)b * SEQ * PINP;
    bf16* Gout = (bf16*)(a.ws + WS_G) + (size_t)b * SEQ * DI;
    LAS float* tbl = (LAS float*)(lds + DF_TBL);
    __syncthreads();
    for (int i = tid; i < DF_TBLN; i += 512) { const int rel = i - 64; tbl[i] = rel < 0 ? -INFINITY : a.rel_bias[t5_bucket(rel) * 32 + 16 + h] * LOG2E; }
    const int q0w = qb * 256 + wave * 32;
    LAS unsigned char* qw = lds + DF_Q + wave * DF_QW;
#pragma unroll
    for (int i = 0; i < 8; ++i) { const int idx = lane + 64 * i, row = idx >> 4, ch = idx & 15;
        v4u v = *(const v4u*)(proj + (size_t)(q0w + row) * PINP + (ch < 8 ? 6144 + h * 64 + ch * 8 : 7168 + h * 64 + (ch - 8) * 8));
#pragma unroll
        for (int k = 0; k < 4; ++k) v[k] = cvtpk(bflo(v[k]) * (0.125f * LOG2E), bfhi(v[k]) * (0.125f * LOG2E));
        *(LAS v4u*)(qw + row * KSTR + ch * 16) = v; }
    const int NT = 4 * qb + 4;
    const int kr_ = 8 * wave + (lane >> 3), kc_ = (lane & 7) ^ ((4 * wave + (lane >> 4)) & 7);
    const bf16* k1src = proj + (size_t)kr_ * PINP + 8192 + h * 64 + kc_ * 8;
    const bf16* k2src = proj + (size_t)kr_ * PINP + 9216 + h * 64 + kc_ * 8;
    const int vr_ = 8 * wave + (lane >> 4), vc_ = (lane & 15) ^ (((lane >> 4) & 3) << 2);
    const bf16* vsrc = proj + (size_t)vr_ * PINP + 10240 + h * 128 + vc_ * 8;
#define DF_DMA(t, bufp) do { const size_t o_ = (size_t)(t) * 64 * PINP; LAS unsigned char* b_ = (bufp) + wave * 1024; \
        GLDS16(k1src + o_, b_); GLDS16(k2src + o_, b_ + 8192); GLDS16(vsrc + o_, b_ + 16384 + wave * 1024); GLDS16(vsrc + o_ + (size_t)4 * PINP, b_ + 16384 + wave * 1024 + 1024); } while (0)
    DF_DMA(0, lds + DF_BUF);
    f32x16 o1[4], o2[4];
#pragma unroll
    for (int c = 0; c < 4; ++c) { o1[c] = f32x16{}; o2[c] = f32x16{}; }
    float m1 = -1e30f, l1 = 0.f, m2 = -1e30f, l2 = 0.f;
    const int qpos = q0w + r32;
    const LAS unsigned char* qrd = qw + r32 * KSTR + hi * 16;
    const int kfo = r32 * 128 + (((hi ^ (r32 >> 1)) & 1) * 16), kxt = ((r32 >> 1) & 6) * 16;
    const int vto = (4 * hi + ((lane & 15) >> 2)) * 256 + ((lane >> 4) & 1) * 32 + (lane & 3) * 8, vxq = 64 * ((lane & 15) >> 2);
    asm volatile("s_waitcnt vmcnt(0)" ::: "memory");
    __syncthreads();
    for (int t = 0; t < NT; ++t) {
        LAS unsigned char* buf = lds + DF_BUF + (t & 1) * DF_BUFB;
        if (t + 1 < NT) DF_DMA(t + 1, lds + DF_BUF + ((t + 1) & 1) * DF_BUFB);
#pragma unroll
        for (int half = 0; half < 2; ++half) {
            const int kb = t * 64 + half * 32;
            if (kb > q0w + 31) continue;
            const LAS unsigned char* k1p = buf + half * 32 * 128 + kfo;
            const LAS unsigned char* k2p = k1p + 8192;
            const int rel0 = qpos - kb - 4 * hi;
            const LAS float* tb = tbl + 64 + min(rel0, 1562);
            f32x16 s1, s2;
#pragma unroll
            for (int r = 0; r < 16; ++r) { s1[r] = tb[-((r & 3) + 8 * (r >> 2))]; s2[r] = s1[r]; }
            __builtin_amdgcn_s_setprio(1);
#pragma unroll
            for (int s = 0; s < 4; ++s) s1 = MFMA32(*(const LAS bf16x8*)(k1p + ((32 * s) ^ kxt)), *(const LAS bf16x8*)(qrd + 32 * s), s1);
#pragma unroll
            for (int s = 0; s < 4; ++s) s2 = MFMA32(*(const LAS bf16x8*)(k2p + ((32 * s) ^ kxt)), *(const LAS bf16x8*)(qrd + 128 + 32 * s), s2);
            __builtin_amdgcn_s_setprio(0);
            const LAS char* vt_ = (const LAS char*)(buf + 16384 + half * 32 * 256 + vto);
            { bf16x8 pb0, pb1; softmax_block<8>(s1, m1, l1, o1, pb0, pb1); pv32s(o1, vt_, vxq, pb0, pb1); }
            { bf16x8 pb0, pb1; softmax_block<8>(s2, m2, l2, o2, pb0, pb1); pv32s(o2, vt_, vxq, pb0, pb1); }
        }
        asm volatile("s_waitcnt vmcnt(0)" ::: "memory");
        __syncthreads();
    }
#undef DF_DMA
    float lam;
    { const float* lv = a.diff_lambda + (size_t)e * 256; const float p1 = wave_sum(lv[lane] * lv[64 + lane]), p2 = wave_sum(lv[128 + lane] * lv[192 + lane]);
      lam = __expf(p1) - __expf(p2) + (layer == 0 ? 0.2f : 0.47071302f); }
    const float i1 = 1.0f / xsum(l1), i2 = lam / xsum(l2);
    float ssq = 0.f;
#pragma unroll
    for (int c = 0; c < 4; ++c)
#pragma unroll
        for (int r = 0; r < 16; ++r) { const float v = o1[c][r] * i1 - o2[c][r] * i2; o1[c][r] = v; ssq += v * v; }
    ssq = xsum(ssq);
    const float lam_init = layer == 0 ? 0.2f : 0.47071302f;
    const float rn = (1.0f / sqrtf(ssq * (1.0f / 128.0f) + EPS)) * (1.0f - lam_init);
    const float* sg = a.diff_subln_g + (size_t)e * 128;
    const bf16* zrow = proj + (size_t)qpos * PINP + 12288 + 2048 + h * 128;
    bf16* orow = Gout + (size_t)qpos * DI + 2048 + h * 128;
    v2u zz[16]; f32x4 gg[16];
#pragma unroll
    for (int i = 0; i < 16; ++i) { const int d0 = 32 * (i >> 2) + 8 * (i & 3) + 4 * hi; zz[i] = *(const v2u*)(zrow + d0); gg[i] = *(const f32x4*)(sg + d0); }
#pragma unroll
    for (int i = 0; i < 16; ++i) asm volatile("" : "+v"(zz[i]), "+v"(gg[i]));
#pragma unroll
    for (int c = 0; c < 4; ++c)
#pragma unroll
        for (int g4 = 0; g4 < 4; ++g4) {
            const int d0 = 32 * c + 8 * g4 + 4 * hi; const v2u z2 = zz[c * 4 + g4]; const f32x4 g2 = gg[c * 4 + g4];
            const float y0 = o1[c][4 * g4 + 0] * rn * g2.x * bflo(z2.x), y1 = o1[c][4 * g4 + 1] * rn * g2.y * bfhi(z2.x),
                        y2 = o1[c][4 * g4 + 2] * rn * g2.z * bflo(z2.y), y3 = o1[c][4 * g4 + 3] * rn * g2.w * bfhi(z2.y);
            v2u w; w.x = cvtpk(y0, y1); w.y = cvtpk(y2, y3);
            *(v2u*)(orow + d0) = w;
        }
}

constexpr int DL_TBL = 0  , DL_V = 2048, DL_VW = 16384  ;
static_assert(DL_V + 8 * DL_VW <= LDS_BARST, "dilated attention LDS map");
__device__ __forceinline__ void dilated_unit(const Args& a, LAS unsigned char* lds, int bh, int blk) {
    const int tid = opaque_tid(), lane = tid & 63, r32 = lane & 31, hi = lane >> 5, wave = __builtin_amdgcn_readfirstlane(tid >> 6);
    const int b = bh >> 4, h = bh & 15, Q0 = blk * 512;
    const bf16* proj = (const bf16*)(a.ws + WS_PROJ) + (size_t)b * SEQ * PINP;
    bf16* OG = (bf16*)(a.ws + WS_OG); float* LSE = (float*)(a.ws + WS_LSE);
    LAS float* tbl = (LAS float*)(lds + DL_TBL);
    __syncthreads();
    for (int i = tid; i < 3 * 132; i += 512) { const int g = i / 132, j = i % 132; tbl[i] = a.rel_bias[t5_bucket(j << (2 * g)) * 32 + h] * LOG2E; }
    __syncthreads();
    LAS unsigned char* vw = lds + DL_V + wave * DL_VW;
    const int vto = (4 * hi + ((lane & 15) >> 2)) * 256 + ((lane >> 4) & 1) * 32 + (lane & 3) * 8, vxq = 64 * ((lane & 15) >> 2);
    const float scl = 0.08838834764831845f * LOG2E;
#pragma unroll 1
    for (int tau = wave; tau < 48; tau += 8) {
        const int g = tau >> 4, sub = tau & 15, dsh = 2 * g, d = 1 << dsh, per = 16 >> dsh;
        const int res = sub / per, ti = sub % per;
        const int tq0 = Q0 + res + d * 32 * ti;
        const int tq = tq0 + d * r32;
        bf16x8 qf[8];
        { const bf16* qp = proj + (size_t)tq * PINP + h * 128 + hi * 8;
#pragma unroll
          for (int s = 0; s < 8; ++s) qf[s] = *(const bf16x8*)(qp + 16 * s); }
        f32x16 o[4];
#pragma unroll
        for (int c = 0; c < 4; ++c) o[c] = f32x16{};
        float m = -1e30f, l = 0.f;
        int kb = 0;
        while (tq0 - 128 * d + d * 32 * kb + 31 * d < 0) ++kb;
        bf16x8 kf[8];
        asm volatile("s_waitcnt lgkmcnt(0)" ::: "memory");
        v_dma(proj, tq0 - 128 * d + d * 32 * kb, d, 4096 + h * 128, lane, vw + (kb & 1) * 8192);
        k_load(proj, tq0 - 128 * d + d * 32 * kb, d, 2048 + h * 128, r32, hi, kf);
#pragma unroll 1
        for (; kb < 5; ++kb) {
            const int tk0 = tq0 - 128 * d + d * 32 * kb;
            asm volatile("s_waitcnt vmcnt(0)" ::: "memory");
            f32x16 s = f32x16{};
#pragma unroll
            for (int ss = 0; ss < 8; ++ss) s = MFMA32(kf[ss], qf[ss], s);
            if (kb < 4) { v_dma(proj, tk0 + d * 32, d, 4096 + h * 128, lane, vw + ((kb + 1) & 1) * 8192);
                          k_load(proj, tk0 + d * 32, d, 2048 + h * 128, r32, hi, kf); }
            const int j0 = r32 + 128 - 32 * kb - 4 * hi;
#pragma unroll
            for (int r = 0; r < 16; ++r) {
                const int kk = (r & 3) + 8 * (r >> 2); const int j = j0 - kk;
                const bool valid = (j >= 0) && (j <= 128) && (tk0 + d * (kk + 4 * hi) >= 0);
                const float bv = tbl[g * 132 + min(max(j, 0), 128)];
                s[r] = valid ? s[r] * scl + bv : -INFINITY;
            }
            bf16x8 pb0, pb1;
            softmax_block<8>(s, m, l, o, pb0, pb1);
            pv32s(o, (const LAS char*)(vw + (kb & 1) * 8192 + vto), vxq, pb0, pb1);
        }
        const float lt = xsum(l); const float il = 1.0f / lt;
        bf16* orow = OG + ((size_t)g * MTOK + (size_t)b * SEQ + tq) * DM + h * 128;
#pragma unroll
        for (int c = 0; c < 4; ++c)
#pragma unroll
            for (int g4 = 0; g4 < 4; ++g4) {
                v2u w; w.x = cvtpk(o[c][4 * g4] * il, o[c][4 * g4 + 1] * il); w.y = cvtpk(o[c][4 * g4 + 2] * il, o[c][4 * g4 + 3] * il);
                *(v2u*)(orow + 32 * c + 8 * g4 + 4 * hi) = w;
            }
        if (hi == 0) LSE[((size_t)g * MTOK + (size_t)b * SEQ + tq) * 16 + h] = (m + __builtin_amdgcn_logf(lt)) * LN2;
    }
    asm volatile("s_waitcnt vmcnt(0)" ::: "memory");
    __threadfence_block();
    __syncthreads();
    bf16* Gout = (bf16*)(a.ws + WS_G) + (size_t)b * SEQ * DI;
    for (int p0 = 0; p0 < 16; p0 += 4) {
        const int ch = tid & 15;
        float e0[4], e1[4], e2[4]; v4u a0[4], a1[4], a2[4], zz[4];
#pragma unroll
        for (int u = 0; u < 4; ++u) {
            const int tq = Q0 + (p0 + u) * 32 + (tid >> 4); const size_t tok = (size_t)b * SEQ + tq;
            e0[u] = LSE[((size_t)0 * MTOK + tok) * 16 + h]; e1[u] = LSE[((size_t)1 * MTOK + tok) * 16 + h]; e2[u] = LSE[((size_t)2 * MTOK + tok) * 16 + h];
            a0[u] = *(const v4u*)(OG + ((size_t)0 * MTOK + tok) * DM + h * 128 + ch * 8); a1[u] = *(const v4u*)(OG + ((size_t)1 * MTOK + tok) * DM + h * 128 + ch * 8);
            a2[u] = *(const v4u*)(OG + ((size_t)2 * MTOK + tok) * DM + h * 128 + ch * 8);
            zz[u] = *(const v4u*)(proj + (size_t)tq * PINP + 12288 + h * 128 + ch * 8);
        }
#pragma unroll
        for (int u = 0; u < 4; ++u) {
            const int tq = Q0 + (p0 + u) * 32 + (tid >> 4);
            const float mx = fmaxf(e0[u], fmaxf(e1[u], e2[u])); float w0 = __expf(e0[u] - mx), w1 = __expf(e1[u] - mx), w2 = __expf(e2[u] - mx);
            const float inv = 1.0f / (w0 + w1 + w2); w0 *= inv; w1 *= inv; w2 *= inv;
            v4u w;
#pragma unroll
            for (int k = 0; k < 4; ++k) {
                const float lo = (w0 * bflo(a0[u][k]) + w1 * bflo(a1[u][k]) + w2 * bflo(a2[u][k])) * bflo(zz[u][k]);
                const float hh = (w0 * bfhi(a0[u][k]) + w1 * bfhi(a1[u][k]) + w2 * bfhi(a2[u][k])) * bfhi(zz[u][k]);
                w[k] = cvtpk(lo, hh);
            }
            *(v4u*)(Gout + (size_t)tq * DI + h * 128 + ch * 8) = w;
        }
    }
}

constexpr int SK_SLOT = 16384, SK_NSLOT = 9, SK_FLAG = SK_NSLOT * SK_SLOT;
static_assert(SK_FLAG + 64 <= LDS_BARST, "stick-breaking LDS map");
__device__ __forceinline__ void stick_unit(const Args& a, LAS unsigned char* lds, int bh, int qb) {
    const int tid = opaque_tid(), lane = tid & 63, r32 = lane & 31, hi = lane >> 5, wave = __builtin_amdgcn_readfirstlane(tid >> 6);
    const int b = bh >> 5, h = bh & 31;
    const bf16* proj = (const bf16*)(a.ws + WS_PROJ) + (size_t)b * SEQ * PINP;
    bf16* Gout = (bf16*)(a.ws + WS_G) + (size_t)b * SEQ * DI;
    LAS unsigned* flags = (LAS unsigned*)(lds + SK_FLAG);
    const int Q0 = qb * 256, q0w = Q0 + wave * 32, qpos = q0w + r32;
    bf16x8 qf[8];
    { const bf16* qp = proj + (size_t)qpos * PINP + h * 128 + hi * 8;
#pragma unroll
      for (int s = 0; s < 8; ++s) qf[s] = *(const bf16x8*)(qp + 16 * s); }
    v2u zz[16];
    { const bf16* zrow = proj + (size_t)qpos * PINP + 12288 + h * 128 + 4 * hi;
#pragma unroll
      for (int i = 0; i < 16; ++i) zz[i] = *(const v2u*)(zrow + 32 * (i >> 2) + 8 * (i & 3)); }
    const int drow = 4 * wave + (lane >> 4);
    const bf16* ksrc = proj + (size_t)drow * PINP + 4096 + h * 128 + (((lane & 15) ^ (drow & 15)) * 8);
    const bf16* vsrc = proj + (size_t)drow * PINP + 8192 + h * 128 + (((lane & 15) ^ (((lane >> 4) & 3) << 2)) * 8);
#define SK_DMA(y) do { const int kb_ = Q0 + 224 - 32 * (y); if (kb_ >= 0) { LAS unsigned char* sl_ = lds + ((y) % SK_NSLOT) * SK_SLOT + wave * 1024; \
        GLDS16(ksrc + (size_t)kb_ * PINP, sl_); GLDS16(vsrc + (size_t)kb_ * PINP, sl_ + 8192); } } while (0)
    __syncthreads();
#pragma unroll 1
    for (int y = 0; y < 8; ++y) SK_DMA(y);
    f32x16 o[4];
#pragma unroll
    for (int c = 0; c < 4; ++c) o[c] = f32x16{};
    float R = 0.f;
    const float scl = 0.08838834764831845f;
    const int kfo = r32 * 256 + (((hi ^ r32) & 1) * 16), kxt = (r32 & 14) * 16;
    const int vto = (4 * hi + ((lane & 15) >> 2)) * 256 + ((lane >> 4) & 1) * 32 + (lane & 3) * 8, vxq = 64 * ((lane & 15) >> 2);
#pragma unroll
    for (int i = 0; i < 16; ++i) asm volatile("" : "+v"(zz[i]));
#pragma unroll 1
    for (int j = 0;; ++j) {
        asm volatile("s_waitcnt vmcnt(0)" ::: "memory");
        __syncthreads();
        if (j > 0) { unsigned alld = 1u;
#pragma unroll
            for (int w = 0; w < 8; ++w) alld &= flags[((j - 1) & 1) * 8 + w];
            if (alld) break; }
        SK_DMA(8 + j);
        const int kb = q0w - 32 * j;
        if (kb >= 0 && !__all(R < -40.0f)) {
            const LAS unsigned char* slot = lds + ((7 - wave + j) % SK_NSLOT) * SK_SLOT;
            f32x16 s = f32x16{};
#pragma unroll
            for (int ss = 0; ss < 8; ++ss) s = MFMA32(*(const LAS bf16x8*)(slot + kfo + ((32 * ss) ^ kxt)), qf[ss], s);
            const bool diag = j == 0;
            const int rel0 = qpos - kb - 4 * hi;
            f32x16 lb;
#pragma unroll
            for (int r = 0; r < 16; ++r) {
                const float z = s[r] * scl;
                const float sp = fmaxf(z, 0.f) + __builtin_amdgcn_logf(1.0f + __builtin_amdgcn_exp2f(-fabsf(z) * LOG2E)) * LN2;
                const bool valid = !diag || (rel0 - ((r & 3) + 8 * (r >> 2)) > 0);
                s[r] = valid ? -sp : 0.f;
                lb[r] = valid ? z - sp : -INFINITY;
            }
            float gs[4], ps[4], E[4];
#pragma unroll
            for (int g = 0; g < 4; ++g) { gs[g] = (s[4 * g] + s[4 * g + 1]) + (s[4 * g + 2] + s[4 * g + 3]); ps[g] = xpartner(gs[g], hi); }
            float run = 0.f;
#pragma unroll
            for (int g = 3; g >= 0; --g) { E[g] = run + (hi == 0 ? ps[g] : 0.f); run += gs[g] + ps[g]; }
#pragma unroll
            for (int g = 0; g < 4; ++g) {
                const float base = R + E[g];
                const float t3 = base, t2 = t3 + s[4 * g + 3], t1 = t2 + s[4 * g + 2], t0 = t1 + s[4 * g + 1];
                s[4 * g + 3] = __builtin_amdgcn_exp2f((lb[4 * g + 3] + t3) * LOG2E); s[4 * g + 2] = __builtin_amdgcn_exp2f((lb[4 * g + 2] + t2) * LOG2E);
                s[4 * g + 1] = __builtin_amdgcn_exp2f((lb[4 * g + 1] + t1) * LOG2E); s[4 * g + 0] = __builtin_amdgcn_exp2f((lb[4 * g + 0] + t0) * LOG2E);
            }
            R += run;
            v4u w0, w1;
            w0.x = cvtpk(s[0], s[1]); w0.y = cvtpk(s[2], s[3]); w0.z = cvtpk(s[4], s[5]); w0.w = cvtpk(s[6], s[7]);
            w1.x = cvtpk(s[8], s[9]); w1.y = cvtpk(s[10], s[11]); w1.z = cvtpk(s[12], s[13]); w1.w = cvtpk(s[14], s[15]);
            pv32s(o, (const LAS char*)(slot + 8192 + vto), vxq, __builtin_bit_cast(bf16x8, w0), __builtin_bit_cast(bf16x8, w1));
        }
        if (lane == 0) flags[(j & 1) * 8 + wave] = (kb - 32 < 0 || __all(R < -40.0f)) ? 1u : 0u;
    }
#undef SK_DMA
    bf16* orow = Gout + (size_t)qpos * DI + h * 128;
#pragma unroll
    for (int c = 0; c < 4; ++c)
#pragma unroll
        for (int g4 = 0; g4 < 4; ++g4) {
            const int d0 = 32 * c + 8 * g4 + 4 * hi;
            const v2u z2 = zz[c * 4 + g4];
            v2u w; w.x = cvtpk(o[c][4 * g4 + 0] * bflo(z2.x), o[c][4 * g4 + 1] * bfhi(z2.x)); w.y = cvtpk(o[c][4 * g4 + 2] * bflo(z2.y), o[c][4 * g4 + 3] * bfhi(z2.y));
            *(v2u*)(orow + d0) = w;
        }
}

#define XB_TMO      128
#define XB_XCNT(j)  (256  + 64 * (j))
#define XB_XSUB(j)  (1280 + 64 * (j))
#define XB_XGEN(j)  (2304 + 64 * (j))
#define XB_TOP      3328
#define XB_TOPGEN   3392
#define XCD_BAR_WORDS 3456
#define XB_SPIN_CAP (1u << 18)

__device__ __forceinline__ unsigned xb_ld(unsigned* p)              { return __hip_atomic_load(p, __ATOMIC_RELAXED, __HIP_MEMORY_SCOPE_AGENT); }
__device__ __forceinline__ unsigned xb_add(unsigned* p, unsigned v) { return __hip_atomic_fetch_add(p, v, __ATOMIC_RELAXED, __HIP_MEMORY_SCOPE_AGENT); }
__device__ __forceinline__ unsigned xb_xcc_id() { return (unsigned)__builtin_amdgcn_s_getreg((3 << 11) | 20) & 0xFu; }
#define XB_SPIN(cond, bar) do { unsigned _sp = 0; while (cond) { __builtin_amdgcn_s_sleep(1); \
    if ((++_sp & 255u) == 0u) { if (xb_ld(&(bar)[XB_TMO])) break; if (_sp > XB_SPIN_CAP) { atomicAdd(&(bar)[XB_TMO], 1u); break; } } } } while (0)

struct XcdBarrier {
    unsigned* bar; unsigned x;
    volatile LAS unsigned* st;
};

__device__ __forceinline__ XcdBarrier xcd_barrier_post(unsigned* bar, volatile LAS unsigned* st) {
    XcdBarrier b; b.bar = bar; b.x = xb_xcc_id(); b.st = st;
    if (threadIdx.x == 0) (void)xb_add(&bar[XB_XCNT(b.x)], 1u);
    return b;
}
__device__ __forceinline__ void xcd_barrier_complete(unsigned* bar, unsigned x, unsigned& nloc, unsigned& nx) {
    const unsigned G = gridDim.x * gridDim.y * gridDim.z;
    unsigned sum, cnt, mine, sp = 0u;
    for (;;) {
        sum = 0u; cnt = 0u; mine = 0u;
#pragma unroll
        for (unsigned j = 0; j < 16; ++j) { const unsigned c = xb_ld(&bar[XB_XCNT(j)]); sum += c; cnt += (c > 0u) ? 1u : 0u; mine = (j == x) ? c : mine; }
        if (sum == G) break;
        __builtin_amdgcn_s_sleep(1);
        if ((++sp & 255u) == 0u) { if (xb_ld(&bar[XB_TMO])) break; if (sp > XB_SPIN_CAP) { atomicAdd(&bar[XB_TMO], 1u); break; } }
    }
    nloc = mine > 0u ? mine : 1u; nx = cnt > 0u ? cnt : 1u;
}

__device__ __forceinline__ void xcd_barrier(const XcdBarrier& b) {
    asm volatile("s_waitcnt vmcnt(0)" ::: "memory");
    __syncthreads();
    if (threadIdx.x == 0) {
        unsigned* bar = b.bar;
        __builtin_amdgcn_s_waitcnt(0);
        unsigned nloc = b.st[0], nx = b.st[1];
        if (nloc == 0u) { xcd_barrier_complete(bar, b.x, nloc, nx); b.st[0] = nloc; b.st[1] = nx; }
        const unsigned old = xb_add(&bar[XB_XSUB(b.x)], 1u);
        const unsigned gen = old / nloc;
        if (old + 1u == (gen + 1u) * nloc) {
            __builtin_amdgcn_fence(__ATOMIC_RELEASE, "agent");
            asm volatile("s_waitcnt vmcnt(0)" ::: "memory");
            const unsigned og = xb_add(&bar[XB_TOP], 1u);
            const unsigned tg = og / nx;
            if (og + 1u == (tg + 1u) * nx) xb_add(&bar[XB_TOPGEN], 1u);
            else XB_SPIN(xb_ld(&bar[XB_TOPGEN]) == tg, bar);
            __builtin_amdgcn_fence(__ATOMIC_ACQUIRE, "agent");
            xb_add(&bar[XB_XGEN(b.x)], 1u);
            asm volatile("s_waitcnt vmcnt(0)" ::: "memory");
        } else {
            XB_SPIN(xb_ld(&bar[XB_XGEN(b.x)]) == gen, bar);
            __builtin_amdgcn_fence(__ATOMIC_ACQUIRE, "agent");
            asm volatile("s_waitcnt vmcnt(0)" ::: "memory");
        }
    }
    __syncthreads();
}

__global__ void __launch_bounds__(512, 2) trunk_fwd(Args a) {
    extern __shared__ __attribute__((aligned(16))) unsigned char smem[];
    LAS unsigned char* lds = (LAS unsigned char*)smem;
    cg::grid_group grid = cg::this_grid();
    const int G = gridDim.x, bx = blockIdx.x;
    const int vcu = (G % 8 == 0) ? (bx % 8) * (G / 8) + bx / 8 : bx;
    unsigned char* ws = a.ws;
    float* H = (float*)(ws + WS_H);
    bf16* U = (bf16*)(ws + WS_U);
    bf16* PROJ = (bf16*)(ws + WS_PROJ);
    bf16* GB = (bf16*)(ws + WS_G);

    unsigned* barw = (unsigned*)(ws + WS_BAR);
    if (bx == 0) for (int i = threadIdx.x; i < CW_WORDS; i += 512) __hip_atomic_store(barw + i, 0u, __ATOMIC_RELAXED, __HIP_MEMORY_SCOPE_AGENT);
    volatile LAS unsigned* barst = (volatile LAS unsigned*)(lds + LDS_BARST);
    if (threadIdx.x < 2) barst[threadIdx.x] = 0u;
    p0_prologue(a, lds, G);
#if PROBE == 1
    __syncthreads(); p0_prologue(a, lds, G);
#endif
    __syncthreads();
    grid.sync();
    const XcdBarrier xbar = xcd_barrier_post(barw, barst);
#define GRID_SYNC() xcd_barrier(xbar)
    const bool fusedn = (G == 256);
#pragma unroll 1
    for (int layer = 0; layer < DEPTH; ++layer) {
        const float* hin = layer == 0 ? a.x : H;
        const float* mod = (const float*)(ws + WS_MOD) + (size_t)layer * NB * NMOD;
        if (layer == 0 || !fusedn) {
            rows_phase<false>(hin, a.norm_g + (size_t)layer * DM, mod, U, nullptr, G);
            GRID_SYNC();
        }
        {
            pg8::Gemm g{U, (const bf16*)(ws + WS_WIN) + (size_t)layer * PIN * DM, MTOK, PIN, DM};
            pg8::StaticOrder S; S.init(MTOK, PIN, G, bx);
            pg8::EpiProj E{PROJ, PINP, 48};
            pg8::gemm_phase<pg8::EpiProj, pg8::StaticOrder, false, true>(lds, g, S, E);
#if PROBE == 2
            __syncthreads(); pg8::gemm_phase<pg8::EpiProj, pg8::StaticOrder, false, true>(lds, g, S, E);
#endif
        }
        GRID_SYNC();
        for (int rep_ = 0; rep_ < ((PROBE == 3 && (layer & 1) == 0) || (PROBE == 4 && (layer & 1) == 1) ? 2 : 1); ++rep_)
        if ((layer & 1) == 0) {
#pragma unroll 1
            for (int pass = 0; pass < 2; ++pass) {
                if (((pass ^ (vcu >> 7)) & 1) == 0) { for (int u = vcu; u < 256; u += G) dilated_unit(a, lds, u >> 3, u & 7); }
                else { for (int p = vcu; p < 256; p += G) { diff_unit(a, lds, layer, p >> 3, p & 7); diff_unit(a, lds, layer, p >> 3, 15 - (p & 7)); } }
            }
        } else {
            for (int u = vcu; u < 1024; u += G) stick_unit(a, lds, u >> 4, u & 15);
        }
        __syncthreads();
        GRID_SYNC();
        {
            pg8::Gemm g{GB, (const bf16*)(ws + WS_WOUT) + (size_t)layer * DM * DI, MTOK, DM, DI};
            pg8::StaticOrder S; S.init(MTOK, DM, G, bx);
            if (fusedn) {
                const bool fin = layer == DEPTH - 1;
                pg8::EpiResNorm E{hin, H, mod + 2 * DM, DM, NMOD, SEQ, fin ? a.final_norm_g : a.norm_g + (size_t)(layer + 1) * DM, fin ? nullptr : mod + NB * NMOD, U, a.out,
                                  (float*)(ws + WS_SLOTS), barw + CW_PANEL + layer * 32 * 64, fin ? 1 : 0};
                pg8::gemm_phase<pg8::EpiResNorm, pg8::StaticOrder, false, true>(lds, g, S, E);
            } else {
                pg8::EpiRes E{hin, H, mod + 2 * DM, DM, NMOD, SEQ};
                pg8::gemm_phase<pg8::EpiRes, pg8::StaticOrder, true, true>(lds, g, S, E);
            }
        }
        if (layer + 1 < DEPTH || !fusedn) GRID_SYNC();
    }
    if (!fusedn) rows_phase<true>(H, a.final_norm_g, nullptr, nullptr, a.out, G);
}

extern "C" void kernel_launch(void* const* d_in, const int* in_sizes, int n_in, void* d_out, int out_size, void* d_ws, size_t ws_size, hipStream_t stream) {
    static int grid = 0;
    if (grid == 0) {
        if (n_in != 11 || out_size != MTOK * DM || ws_size < WS_END) { fprintf(stderr, "kernel_launch: unexpected shapes (n_in %d out %d ws %zu)\n", n_in, out_size, ws_size); grid = -1; return; }
        int dev = 0, cus = 0, per_cu = 0;
        (void)hipGetDevice(&dev);
        (void)hipDeviceGetAttribute(&cus, hipDeviceAttributeMultiprocessorCount, dev);
        (void)hipFuncSetAttribute((const void*)trunk_fwd, hipFuncAttributeMaxDynamicSharedMemorySize, LDS_BYTES);
        if (hipOccupancyMaxActiveBlocksPerMultiprocessor(&per_cu, (const void*)trunk_fwd, 512, LDS_BYTES) != hipSuccess || per_cu < 1) { fprintf(stderr, "kernel_launch: occupancy query says %d\n", per_cu); per_cu = 1; }
        (void)hipGetLastError();
        grid = cus * per_cu;
    }
    if (grid < 0) return;
    Args a{};
    a.x = (const float*)d_in[0]; a.c = (const float*)d_in[1]; a.norm_g = (const float*)d_in[2]; a.w_mod = (const float*)d_in[3]; a.b_mod = (const float*)d_in[4];
    a.w_in = (const float*)d_in[5]; a.w_out = (const float*)d_in[6]; a.rel_bias = (const float*)d_in[7]; a.diff_lambda = (const float*)d_in[8];
    a.diff_subln_g = (const float*)d_in[9]; a.final_norm_g = (const float*)d_in[10]; a.out = (float*)d_out; a.ws = (unsigned char*)d_ws;
    void* args[] = {&a};
    hipError_t e = hipLaunchCooperativeKernel((const void*)trunk_fwd, dim3(grid), dim3(512), args, LDS_BYTES, stream);
    if (e != hipSuccess) fprintf(stderr, "cooperative launch failed: %s (grid %d)\n", hipGetErrorString(e), grid);
}
```
